# Optimizing an MI355X kernel written in HIP

```python
import math
import jax, jax.numpy as jnp
from jax import lax
import numpy as np

D_MODEL = 2048
BATCH = 2
SEQ = 16384
DEPTH = 2

D_MIX = D_MODEL
NSA_HEADS = 16
NSA_KV_HEADS = 4
NSA_HEAD_DIM = 64
NSA_GROUP = NSA_HEADS // NSA_KV_HEADS
CMP_LEN = 32
CMP_STRIDE = 16
CMP_HIDDEN = 128
SEL_BLOCK = 64
N_SEL = 16
WINDOW = 512
Q_BLOCK = 128
ML_HEADS = 4
ML_HEAD_DIM = 128
ML_CHUNK = 64
ML_CONV = 4
RW_HEADS = 8
RW_HEAD_DIM = 64
RW_DECAY_RANK = 64
RW_AICL_RANK = 64
RW_GATE_RANK = 128
D_FF = 5632
REL_BUCKETS = 32
REL_MAX_DIST = 128

NORM_EPS = 1e-6
RW_LN_EPS = 64e-5
MASK_NEG = -1e30

NSA_W = NSA_HEADS * NSA_HEAD_DIM
NSA_KV_W = NSA_KV_HEADS * NSA_HEAD_DIM
ML_W = ML_HEADS * ML_HEAD_DIM
RW_W = RW_HEADS * RW_HEAD_DIM
NSA_COLS = NSA_W + 6 * NSA_KV_W + 3 * NSA_HEADS
ML_COLS = 4 * ML_W + 2 * ML_HEADS
RW_COLS = 3 * RW_W + RW_DECAY_RANK + RW_AICL_RANK + RW_GATE_RANK
N_IN = NSA_COLS + ML_COLS + RW_COLS

kernel_name = "hybrid_nsa_mlstm_rwkv7_macaron"


def split_cols(z, sizes):
    return jnp.split(z, np.cumsum(sizes)[:-1].tolist(), axis=-1)


def rmsnorm(x, g):
    x32 = x.astype(jnp.float32)
    y = x32 * lax.rsqrt(jnp.mean(x32 * x32, axis=-1, keepdims=True) + NORM_EPS)
    return (y * g.astype(jnp.float32)).astype(x.dtype)


def head_norm(y, g, eps):
    mu = jnp.mean(y, axis=-1, keepdims=True)
    var = jnp.mean(jnp.square(y - mu), axis=-1, keepdims=True)
    return (y - mu) * lax.rsqrt(var + eps) * g.astype(jnp.float32).reshape(y.shape[-2:])


def swiglu(h, w_gate, w_up, w_down):
    return (jax.nn.silu(h @ w_gate) * (h @ w_up)) @ w_down


def rel_bucket(dist):
    n = jnp.maximum(dist, 0)
    max_exact = REL_BUCKETS // 2
    large = max_exact + (jnp.log(jnp.maximum(n, max_exact).astype(jnp.float32) / max_exact)
                         / math.log(REL_MAX_DIST / max_exact) * (REL_BUCKETS - max_exact)).astype(jnp.int32)
    return jnp.where(n < max_exact, n, jnp.minimum(large, REL_BUCKETS - 1))


def compress_kv(kv, pos, w1, w2):
    b_, t_, kvh, hd = kv.shape
    n_cmp = t_ // CMP_STRIDE
    kp = jnp.pad(kv, ((0, 0), (0, CMP_STRIDE), (0, 0), (0, 0))).reshape(b_, n_cmp + 1, CMP_STRIDE, kvh, hd)
    blocks = jnp.concatenate([kp[:, :-1], kp[:, 1:]], axis=2) + pos[None, None, :, None, :]
    flat = blocks.transpose(0, 3, 1, 2, 4).reshape(b_, kvh, n_cmp, CMP_LEN * hd)
    return jax.nn.silu(flat @ w1) @ w2


def nsa_attention(q, k_cmp, v_cmp, k_slc, v_slc, k_win, v_win, gates, rel_bias):
    b_, kvh, g_, t_, hd = q.shape
    n_cmp = k_cmp.shape[2]
    n_blk = k_slc.shape[2]
    n_sel = min(N_SEL, n_blk)
    tab = rel_bias.astype(jnp.float32)
    tab_g = tab.reshape(kvh, g_, REL_BUCKETS)
    cmp_end = jnp.arange(n_cmp, dtype=jnp.int32) * CMP_STRIDE + (CMP_LEN - 1)
    blk_ids = jnp.arange(n_blk, dtype=jnp.int32)
    bi = jnp.arange(b_)[:, None, None, None]
    hi = jnp.arange(kvh)[None, :, None, None]
    hi6 = jnp.arange(kvh)[None, :, None, None, None, None]
    gi6 = jnp.arange(g_)[None, None, :, None, None, None]

    def block(qb):
        s0 = qb * Q_BLOCK
        t = s0 + jnp.arange(Q_BLOCK, dtype=jnp.int32)
        qq = lax.dynamic_slice_in_dim(q, s0, Q_BLOCK, axis=3)
        d_cmp = t[:, None] - cmp_end[None, :]
        ok_cmp = d_cmp >= 0
        s = (jnp.einsum('bhgqd,bhnd->bhgqn', qq, k_cmp).astype(jnp.float32)
             + tab[:, rel_bucket(d_cmp)].reshape(kvh, g_, Q_BLOCK, n_cmp))
        p_cmp = jax.nn.softmax(jnp.where(ok_cmp, s, MASK_NEG), axis=-1) * ok_cmp.any(-1)[:, None]
        o_cmp = jnp.einsum('bhgqn,bhnd->bhgqd', p_cmp.astype(v_cmp.dtype), v_cmp)
        imp = p_cmp.sum(2).reshape(b_, kvh, Q_BLOCK, n_blk, SEL_BLOCK // CMP_STRIDE)
        score = imp.sum(-1) + jnp.pad(imp[..., :-1, -1], ((0, 0), (0, 0), (0, 0), (1, 0)))
        cur = t // SEL_BLOCK
        forced = (blk_ids[None, :] == 0) | (blk_ids[None, :] == cur[:, None]) | (blk_ids[None, :] == cur[:, None] - 1)
        ok_blk = blk_ids[None, :] * SEL_BLOCK <= t[:, None]
        score = jnp.where(forced, -MASK_NEG, jnp.where(ok_blk, score, MASK_NEG))
        _, idx = lax.top_k(score, n_sel)
        kg = k_slc[bi, hi, idx]
        vg = v_slc[bi, hi, idx]
        pos = idx[..., None] * SEL_BLOCK + jnp.arange(SEL_BLOCK, dtype=jnp.int32)
        d_slc = (t[:, None, None] - pos)[:, :, None]
        s = (jnp.einsum('bhgqd,bhqnld->bhgqnl', qq, kg).astype(jnp.float32)
             + tab_g[hi6, gi6, rel_bucket(d_slc)])
        s = jnp.where(d_slc >= 0, s, MASK_NEG)
        p = jax.nn.softmax(s.reshape(b_, kvh, g_, Q_BLOCK, -1), axis=-1).reshape(s.shape)
        o_slc = jnp.einsum('bhgqnl,bhqnld->bhgqd', p.astype(vg.dtype), vg)
        kw = lax.dynamic_slice_in_dim(k_win, s0, WINDOW + Q_BLOCK, axis=2)
        vw = lax.dynamic_slice_in_dim(v_win, s0, WINDOW + Q_BLOCK, axis=2)
        kpos = s0 - WINDOW + jnp.arange(WINDOW + Q_BLOCK, dtype=jnp.int32)
        d_win = t[:, None] - kpos[None, :]
        ok_win = (d_win >= 0) & (d_win < WINDOW) & (kpos >= 0)[None, :]
        s = (jnp.einsum('bhgqd,bhkd->bhgqk', qq, kw).astype(jnp.float32)
             + tab[:, rel_bucket(d_win)].reshape(kvh, g_, Q_BLOCK, -1))
        p = jax.nn.softmax(jnp.where(ok_win, s, MASK_NEG), axis=-1)
        o_win = jnp.einsum('bhgqk,bhkd->bhgqd', p.astype(vw.dtype), vw)
        gq = lax.dynamic_slice_in_dim(gates, s0, Q_BLOCK, axis=3).astype(qq.dtype)
        o = gq[..., 0:1] * o_cmp + gq[..., 1:2] * o_slc + gq[..., 2:3] * o_win
        return o.transpose(0, 3, 1, 2, 4).reshape(b_, Q_BLOCK, kvh * g_ * hd)

    out = lax.map(block, jnp.arange(t_ // Q_BLOCK, dtype=jnp.int32))
    return out.transpose(1, 0, 2, 3).reshape(b_, t_, kvh * g_ * hd)


def nsa_group(z, rel_bias, cmp_pos, cmp_w1, cmp_w2):
    b_, t_, _ = z.shape
    q, kc, vc, ks, vs, kw, vw, gt = split_cols(z, [NSA_W] + [NSA_KV_W] * 6 + [3 * NSA_HEADS])
    q = q.reshape(b_, t_, NSA_KV_HEADS, NSA_GROUP, NSA_HEAD_DIM).transpose(0, 2, 3, 1, 4) * NSA_HEAD_DIM ** -0.5
    kv4 = lambda a: a.reshape(b_, t_, NSA_KV_HEADS, NSA_HEAD_DIM)
    k_cmp = compress_kv(kv4(kc), cmp_pos[0], cmp_w1[0], cmp_w2[0])
    v_cmp = compress_kv(kv4(vc), cmp_pos[1], cmp_w1[1], cmp_w2[1])
    blocks = lambda a: kv4(a).transpose(0, 2, 1, 3).reshape(b_, NSA_KV_HEADS, t_ // SEL_BLOCK, SEL_BLOCK, NSA_HEAD_DIM)
    band = lambda a: jnp.pad(kv4(a).transpose(0, 2, 1, 3), ((0, 0), (0, 0), (WINDOW, 0), (0, 0)))
    gates = jax.nn.sigmoid(gt.astype(jnp.float32)).reshape(b_, t_, NSA_KV_HEADS, NSA_GROUP, 3).transpose(0, 2, 3, 1, 4)
    return nsa_attention(q, k_cmp, v_cmp, blocks(ks), blocks(vs), band(kw), band(vw), gates, rel_bias)


def causal_depthwise_conv(x, w, b):
    k_ = w.shape[0]
    t_ = x.shape[1]
    xp = jnp.pad(x, ((0, 0), (k_ - 1, 0), (0, 0)))
    return sum(xp[:, j:j + t_] * w[j] for j in range(k_)) + b


def mlstm_chunkwise(q, k, v, i_pre, f_pre):
    b_, t_, h_, d_ = q.shape
    L = ML_CHUNK
    nc = t_ // L
    ch4 = lambda a: a.reshape(b_, nc, L, h_, d_).transpose(1, 0, 3, 2, 4)
    ch3 = lambda a: a.reshape(b_, nc, L, h_).transpose(1, 0, 3, 2)
    qc, kc, vc = ch4(q), ch4(k * d_ ** -0.5), ch4(v)
    ic = ch3(i_pre)
    bc = jnp.cumsum(ch3(jax.nn.log_sigmoid(f_pre)), axis=-1)
    causal = jnp.tril(jnp.ones((L, L), dtype=bool))

    def step(carry, inp):
        C, n, m = carry
        qx, kx, vx, ix, bx = inp
        g = bx[..., -1]
        log_d = jnp.where(causal, bx[..., :, None] - bx[..., None, :] + ix[..., None, :], -jnp.inf)
        m_inter = bx + m[..., None]
        m_t = jnp.maximum(log_d.max(-1), m_inter)
        s = jnp.einsum('bhtd,bhsd->bhts', qx, kx) * jnp.exp(log_d - m_t[..., None])
        w_inter = jnp.exp(m_inter - m_t)
        num = jnp.einsum('bhts,bhsd->bhtd', s, vx) + w_inter[..., None] * jnp.einsum('bhtd,bhde->bhte', qx, C)
        den = s.sum(-1) + w_inter * jnp.einsum('bhtd,bhd->bht', qx, n)
        h = num / jnp.maximum(jnp.abs(den), jnp.exp(-m_t))[..., None]
        log_w = g[..., None] - bx + ix
        m_new = jnp.maximum(g + m, log_w.max(-1))
        wk = jnp.exp(log_w - m_new[..., None])
        dec = jnp.exp(g + m - m_new)
        C = dec[..., None, None] * C + jnp.einsum('bhs,bhsd,bhse->bhde', wk, kx, vx)
        n = dec[..., None] * n + jnp.einsum('bhs,bhsd->bhd', wk, kx)
        return (C, n, m_new), h

    init = (jnp.zeros((b_, h_, d_, d_), jnp.float32), jnp.zeros((b_, h_, d_), jnp.float32),
            jnp.zeros((b_, h_), jnp.float32))
    _, hs = lax.scan(step, init, (qc, kc, vc, ic, bc))
    return hs.transpose(1, 0, 3, 2, 4).reshape(b_, t_, h_, d_)


def mlstm_group(z, conv_w, conv_b, gate_b, norm_g):
    b_, t_, _ = z.shape
    qk, v, o, ig, fg = split_cols(z, [2 * ML_W, ML_W, ML_W, ML_HEADS, ML_HEADS])
    qk = jax.nn.silu(causal_depthwise_conv(qk, conv_w, conv_b)).astype(jnp.float32)
    q, k = jnp.split(qk, 2, axis=-1)
    hd = lambda a: a.astype(jnp.float32).reshape(b_, t_, ML_HEADS, ML_HEAD_DIM)
    i_pre = ig.astype(jnp.float32) + gate_b[0].astype(jnp.float32)
    f_pre = fg.astype(jnp.float32) + gate_b[1].astype(jnp.float32)
    h = mlstm_chunkwise(hd(q), hd(k), hd(v), i_pre, f_pre)
    h = jax.nn.sigmoid(hd(o)) * h
    return head_norm(h, norm_g, NORM_EPS).reshape(b_, t_, ML_W).astype(z.dtype)


def rwkv7_scan(r, w, k, v, kk, a):
    b_, t_, h_, d_ = r.shape
    seq = tuple(jnp.moveaxis(u, 1, 0) for u in (r, w, k, v, -kk, kk * a))

    def step(S, inp):
        rt, wt, kt, vt, at, bt = inp
        sa = jnp.einsum('bhij,bhj->bhi', S, at)
        S = S * wt[:, :, None, :] + sa[..., None] * bt[:, :, None, :] + vt[..., None] * kt[:, :, None, :]
        return S, jnp.einsum('bhij,bhj->bhi', S, rt)

    _, y = lax.scan(step, jnp.zeros((b_, h_, d_, d_), jnp.float32), seq)
    return jnp.moveaxis(y, 0, 1)


def rwkv_group(z, mu, w0, w_up, a0, a_up, g_up, k_k, k_a, r_k, ln):
    b_, t_, _ = z.shape
    z_prev = jnp.pad(z, ((0, 0), (1, 0), (0, 0)))[:, :-1]
    z = z + mu * (z_prev - z)
    r, k, v, wd, ad, gd = [u.astype(jnp.float32) for u in
                           split_cols(z, [RW_W, RW_W, RW_W, RW_DECAY_RANK, RW_AICL_RANK, RW_GATE_RANK])]
    f32 = lambda p: p.astype(jnp.float32)
    w_log = -jax.nn.softplus(-(f32(w0) + jnp.tanh(wd) @ f32(w_up))) - 0.5
    decay = jnp.exp(-jnp.exp(w_log))
    a = jax.nn.sigmoid(f32(a0) + ad @ f32(a_up))
    g = jax.nn.sigmoid(gd) @ f32(g_up)
    hd = lambda u: u.reshape(b_, t_, RW_HEADS, RW_HEAD_DIM)
    kk = hd(k * f32(k_k))
    kk = kk / jnp.maximum(jnp.linalg.norm(kk, axis=-1, keepdims=True), 1e-12)
    k = k * (1.0 + (a - 1.0) * f32(k_a))
    r4, k4, v4 = hd(r), hd(k), hd(v)
    y = rwkv7_scan(r4, hd(decay), k4, v4, kk, hd(a))
    y = head_norm(y, ln[0], RW_LN_EPS) + f32(ln[1]).reshape(RW_HEADS, RW_HEAD_DIM)
    y = y + jnp.sum(r4 * k4 * f32(r_k), axis=-1, keepdims=True) * v4
    return (y.reshape(b_, t_, RW_W) * g).astype(z.dtype)


def setup_inputs(seed: int = 0) -> dict:
    key = jax.random.key(seed)
    ks = iter(jax.random.split(key, 48))
    nrm = lambda shape, scale: jax.random.normal(next(ks), shape, jnp.float32) * scale
    hdim = NSA_HEAD_DIM
    return {
        "x": nrm((BATCH, SEQ, D_MODEL), 1.0),
        "c": nrm((BATCH, D_MODEL), 1.0),
        "rel_bias": nrm((NSA_HEADS, REL_BUCKETS), 0.5),
        "final_norm": 1.0 + nrm((D_MODEL,), 0.02),
        "ada_w": nrm((DEPTH, D_MODEL, 9 * D_MODEL), 0.5 * D_MODEL ** -0.5),
        "ada_b": nrm((DEPTH, 9 * D_MODEL), 0.02),
        "norm_g": 1.0 + nrm((DEPTH, 3, D_MODEL), 0.02),
        "ffn_w_gate": nrm((DEPTH, 2, D_MODEL, D_FF), D_MODEL ** -0.5),
        "ffn_w_up": nrm((DEPTH, 2, D_MODEL, D_FF), D_MODEL ** -0.5),
        "ffn_w_down": nrm((DEPTH, 2, D_FF, D_MODEL), D_FF ** -0.5),
        "w_in": nrm((DEPTH, D_MODEL, N_IN), D_MODEL ** -0.5),
        "w_out": nrm((DEPTH, D_MIX, D_MODEL), D_MIX ** -0.5),
        "cmp_pos": nrm((DEPTH, 2, CMP_LEN, hdim), 0.1),
        "cmp_w1": nrm((DEPTH, 2, CMP_LEN * hdim, CMP_HIDDEN), (CMP_LEN * hdim) ** -0.5),
        "cmp_w2": nrm((DEPTH, 2, CMP_HIDDEN, hdim), CMP_HIDDEN ** -0.5),
        "ml_conv_w": nrm((DEPTH, ML_CONV, 2 * ML_W), ML_CONV ** -0.5),
        "ml_conv_b": nrm((DEPTH, 2 * ML_W), 0.02),
        "ml_gate_b": jnp.stack([nrm((DEPTH, ML_HEADS), 0.1),
                                jnp.linspace(3.0, 6.0, ML_HEADS)[None, :] + nrm((DEPTH, ML_HEADS), 0.1)], axis=1),
        "ml_norm": 1.0 + nrm((DEPTH, ML_W), 0.02),
        "rw_mu": jax.random.uniform(next(ks), (DEPTH, RW_COLS), jnp.float32),
        "rw_w0": nrm((DEPTH, RW_W), 0.5),
        "rw_w_up": nrm((DEPTH, RW_DECAY_RANK, RW_W), 0.1),
        "rw_a0": nrm((DEPTH, RW_W), 0.5),
        "rw_a_up": nrm((DEPTH, RW_AICL_RANK, RW_W), 0.1),
        "rw_g_up": nrm((DEPTH, RW_GATE_RANK, RW_W), RW_GATE_RANK ** -0.5),
        "rw_k_k": 0.85 + nrm((DEPTH, RW_W), 0.05),
        "rw_k_a": 1.0 + nrm((DEPTH, RW_W), 0.05),
        "rw_r_k": nrm((DEPTH, RW_HEADS, RW_HEAD_DIM), 0.1),
        "rw_ln": jnp.stack([1.0 + nrm((DEPTH, RW_W), 0.02), nrm((DEPTH, RW_W), 0.02)], axis=1),
    }


def reference(x, c, rel_bias, final_norm, ada_w, ada_b, norm_g, ffn_w_gate, ffn_w_up, ffn_w_down,
              w_in, w_out, cmp_pos, cmp_w1, cmp_w2, ml_conv_w, ml_conv_b, ml_gate_b, ml_norm,
              rw_mu, rw_w0, rw_w_up, rw_a0, rw_a_up, rw_g_up, rw_k_k, rw_k_a, rw_r_k, rw_ln):
    b_ = x.shape[0]
    cond = jax.nn.silu(c)
    for l in range(DEPTH):
        mod = (cond @ ada_w[l] + ada_b[l]).reshape(b_, 3, 3, D_MODEL)

        def adaln(u, i):
            return rmsnorm(u, norm_g[l, i]) * (1.0 + mod[:, i, 1, None]) + mod[:, i, 0, None]

        h = adaln(x, 0)
        x = x + 0.5 * mod[:, 0, 2, None] * swiglu(h, ffn_w_gate[l, 0], ffn_w_up[l, 0], ffn_w_down[l, 0])
        h = adaln(x, 1)
        z = h @ w_in[l]
        z_nsa, z_ml, z_rw = jnp.split(z, [NSA_COLS, NSA_COLS + ML_COLS], axis=-1)
        y_nsa = nsa_group(z_nsa, rel_bias, cmp_pos[l], cmp_w1[l], cmp_w2[l])
        y_ml = mlstm_group(z_ml, ml_conv_w[l], ml_conv_b[l], ml_gate_b[l], ml_norm[l])
        y_rw = rwkv_group(z_rw, rw_mu[l], rw_w0[l], rw_w_up[l], rw_a0[l], rw_a_up[l], rw_g_up[l],
                          rw_k_k[l], rw_k_a[l], rw_r_k[l], rw_ln[l])
        y = jnp.concatenate([y_nsa, y_ml, y_rw], axis=-1) @ w_out[l]
        x = x + mod[:, 1, 2, None] * y
        h = adaln(x, 2)
        x = x + 0.5 * mod[:, 2, 2, None] * swiglu(h, ffn_w_gate[l, 1], ffn_w_up[l, 1], ffn_w_down[l, 1])
    return rmsnorm(x, final_norm)
```

```cpp
#include <hip/hip_runtime.h>
#include <cstdio>
#include <cstdint>
#include <cstddef>
namespace pg8 {
#define PG8_LAS __attribute__((address_space(3)))
typedef unsigned short bf16_t;
typedef short bf16x8 __attribute__((ext_vector_type(8)));
typedef float f32x4 __attribute__((ext_vector_type(4)));
typedef unsigned u32x4 __attribute__((ext_vector_type(4)));
constexpr int BM = 256, BK = 64, HALF = 128, HTB = HALF * BK * 2  , STAGE_BYTES = 8 * HTB, NXCD = 8, WGM = 8;

__host__ __device__ __forceinline__ int lds_byte(int r, int c) { const int st = (r >> 4) * 2 + (c >> 5), rr = r & 15, cc = c & 31, ob = rr * 64 + cc * 2; return st * 1024 + (ob ^ (((ob >> 9) & 1) << 5)); }
__host__ __device__ __forceinline__ void stage_rc(int b, int& R, int& C) { const int st = b / 1024, sb = b % 1024, swz = sb ^ (((sb >> 9) & 1) << 5); R = (st >> 1) * 16 + swz / 64; C = (st & 1) * 32 + (swz % 64) / 2; }
__host__ __device__ __forceinline__ int perm32(int rho) { const int n = rho >> 4, i = rho & 15; return 8 * (i >> 2) + 4 * n + (i & 3); }

struct Unit { int pm, pn; };
struct Gemm { const bf16_t* A; const bf16_t* Bt; int M, N, K; };

struct StaticOrder {
    int nM, nN, nwg, G, c;
    __host__ __device__ void init(int M, int N, int G_, int c_) { nM = M / BM; nN = N / BM; nwg = nM * nN; G = G_; c = c_; }
    __host__ __device__ bool next(int i, Unit& u) const {
        const long L = (long)i * G + c; if (L >= nwg) return false;
        int wgid = (int)L; { const int q = nwg / NXCD, r = nwg % NXCD, xcd = wgid % NXCD, off = wgid / NXCD; wgid = (xcd < r ? xcd * (q + 1) : r * (q + 1) + (xcd - r) * q) + off; }
        const int nig = WGM * nN, gid = wgid / nig, fm = gid * WGM, gsz = (nM - fm) < WGM ? (nM - fm) : WGM;
        u.pm = fm + ((wgid % nig) % gsz); u.pn = (wgid % nig) / gsz; return true;
    }
    __device__ __forceinline__ void a_ready(const Unit&) const {}
    __device__ __forceinline__ void done(const Unit&) const {}
};
__device__ __forceinline__ unsigned cvt_pk_bf16(float lo, float hi) { unsigned r; asm volatile("v_cvt_pk_bf16_f32 %0, %1, %2" : "=v"(r) : "v"(lo), "v"(hi)); return r; }

__device__ __forceinline__ float fast_silu_mul(float g, float u) { const float e = __builtin_amdgcn_exp2f(-1.44269504089f * g); return g * u * __builtin_amdgcn_rcpf(1.0f + e); }
struct EpiPlainBf16 {
    static constexpr bool PERM = true, AFTER_DRAIN = false;
    bf16_t* O; int ldc;
    __device__ __forceinline__ void operator()(const f32x4 (&acc)[2][2][4][2], const Unit& u, int wr, int wc, int fr, int fq) const {
        const int row0 = u.pm * BM + wr * 64 + fr, col0 = u.pn * BM + wc * 32 + 8 * fq;
#pragma unroll
        for (int ai = 0; ai < 2; ++ai)
#pragma unroll
            for (int m = 0; m < 4; ++m) { bf16_t* rowp = O + (size_t)(row0 + ai * HALF + m * 16) * ldc + col0;
#pragma unroll
                for (int bj = 0; bj < 2; ++bj) { const f32x4 v0 = acc[ai][bj][m][0], v1 = acc[ai][bj][m][1];
                    u32x4 w; w.x = cvt_pk_bf16(v0[0], v0[1]); w.y = cvt_pk_bf16(v0[2], v0[3]); w.z = cvt_pk_bf16(v1[0], v1[1]); w.w = cvt_pk_bf16(v1[2], v1[3]);
                    *(u32x4*)(rowp + bj * HALF) = w; } }
    }
};
struct EpiSwiGLU {
    static constexpr bool PERM = true, AFTER_DRAIN = false;
    bf16_t* O; int ldc;
    __device__ __forceinline__ void operator()(const f32x4 (&acc)[2][2][4][2], const Unit& u, int wr, int wc, int fr, int fq) const {
        const int row0 = u.pm * BM + wr * 64 + fr, col0 = u.pn * HALF + wc * 32 + 8 * fq;
#pragma unroll
        for (int ai = 0; ai < 2; ++ai)
#pragma unroll
            for (int m = 0; m < 4; ++m) { bf16_t* rowp = O + (size_t)(row0 + ai * HALF + m * 16) * ldc + col0;
                const f32x4 g0 = acc[ai][0][m][0], g1 = acc[ai][0][m][1], u0 = acc[ai][1][m][0], u1 = acc[ai][1][m][1];
                u32x4 w;
                w.x = cvt_pk_bf16(fast_silu_mul(g0[0], u0[0]), fast_silu_mul(g0[1], u0[1])); w.y = cvt_pk_bf16(fast_silu_mul(g0[2], u0[2]), fast_silu_mul(g0[3], u0[3]));
                w.z = cvt_pk_bf16(fast_silu_mul(g1[0], u1[0]), fast_silu_mul(g1[1], u1[1])); w.w = cvt_pk_bf16(fast_silu_mul(g1[2], u1[2]), fast_silu_mul(g1[3], u1[3]));
                *(u32x4*)rowp = w; }
    }
};
template <int ldc, int gstride, int rows_per_batch, int SCALE_X2> struct EpiGateBf16 {
    static constexpr bool PERM = true, AFTER_DRAIN = false; static constexpr float scale = 0.5f * SCALE_X2;
    bf16_t* O; const float* gate;
    __device__ __forceinline__ void operator()(const f32x4 (&acc)[2][2][4][2], const Unit& u, int wr, int wc, int fr, int fq) const {
        const int row0 = u.pm * BM + wr * 64 + fr, col0 = u.pn * BM + wc * 32 + 8 * fq;
        const int b = (u.pm * BM) / rows_per_batch;
#pragma unroll
        for (int bj = 0; bj < 2; ++bj) { const float* gp = gate + (size_t)b * gstride + col0 + bj * HALF; const f32x4 g0 = *(const f32x4*)gp * scale, g1 = *(const f32x4*)(gp + 4) * scale;
#pragma unroll
            for (int ai = 0; ai < 2; ++ai)
#pragma unroll
                for (int m = 0; m < 4; ++m) { bf16_t* rowp = O + (size_t)(row0 + ai * HALF + m * 16) * ldc + col0 + bj * HALF;
                    const f32x4 v0 = acc[ai][bj][m][0] * g0, v1 = acc[ai][bj][m][1] * g1;
                    u32x4 w; w.x = cvt_pk_bf16(v0[0], v0[1]); w.y = cvt_pk_bf16(v0[2], v0[3]); w.z = cvt_pk_bf16(v1[0], v1[1]); w.w = cvt_pk_bf16(v1[2], v1[3]);
                    *(u32x4*)rowp = w; } }
    }
};
struct EpiResid {
    static constexpr bool PERM = false, AFTER_DRAIN = false;
    const float* base; float* out; int ldc; const float* gate; int gstride; int rows_per_batch; float scale;
    __device__ __forceinline__ void operator()(const f32x4 (&acc)[2][2][4][2], const Unit& u, int wr, int wc, int fr, int fq) const {
        const int row0 = u.pm * BM + wr * 64 + fr, col0 = u.pn * BM + wc * 32 + 4 * fq;
        const int b = (u.pm * BM) / rows_per_batch;
        f32x4 gv[2][2];
#pragma unroll
        for (int bj = 0; bj < 2; ++bj)
#pragma unroll
            for (int n = 0; n < 2; ++n) gv[bj][n] = *(const f32x4*)(gate + (size_t)b * gstride + col0 + bj * HALF + n * 16) * scale;
#pragma unroll
        for (int ai = 0; ai < 2; ++ai)
#pragma unroll
            for (int m = 0; m < 4; ++m) { const size_t off = (size_t)(row0 + ai * HALF + m * 16) * ldc + col0;
#pragma unroll
                for (int bj = 0; bj < 2; ++bj)
#pragma unroll
                    for (int n = 0; n < 2; ++n) { const f32x4 bs = *(const f32x4*)(base + off + bj * HALF + n * 16);
                        *(f32x4*)(out + off + bj * HALF + n * 16) = bs + acc[ai][bj][m][n] * gv[bj][n]; } }
    }
};
template <class Epi, class Sched, bool ALIGN_EPI = false, bool SP2 = false>
__device__ __forceinline__ void gemm_phase(PG8_LAS unsigned char* lds, const Gemm g, const Sched& S, const Epi& E, const int tid) {
    const int wid = __builtin_amdgcn_readfirstlane(tid >> 6), lane = tid & 63, wr = wid >> 2, wc = wid & 3, fr = lane & 15, fq = lane >> 4;
    const int K = g.K, nt = K / BK;
    unsigned voffA[2], voffB[2];
#pragma unroll
    for (int i = 0; i < 2; ++i) { int R, C; stage_rc(tid * 16 + i * 8192, R, C); const int Rb = Epi::PERM ? ((R & ~31) + perm32(R & 31)) : R;
        voffA[i] = (unsigned)(R * K + C) * 2u; voffB[i] = (unsigned)(Rb * K + C) * 2u; }
    const size_t kstep = (size_t)(BK * 2);
    const size_t hstep = (size_t)HALF * K * 2;
    const size_t tstep = 2 * hstep;
    const unsigned ldsw = (unsigned)wid * 1024u;
    const int aoff = lds_byte(wr * 64 + fr, fq * 8), boff = lds_byte(wc * 32 + fr, fq * 8);
#define PG8_SA(b, h) (((b) * 2 + (h)) * HTB)
#define PG8_SB(b, h) ((4 + (b) * 2 + (h)) * HTB)
#define PG8_STAGE(bufoff, gbase, voff) do { _Pragma("unroll") for (int _i = 0; _i < 2; ++_i) \
        __builtin_amdgcn_global_load_lds((const unsigned*)((const char*)(gbase) + (voff)[_i]), (PG8_LAS unsigned*)(lds + (bufoff) + ldsw + _i * 8192), 16, 0, 0); } while (0)
#define PG8_LDA(dst, b, h) do { _Pragma("unroll") for (int m = 0; m < 4; ++m) _Pragma("unroll") for (int k = 0; k < 2; ++k) dst[m][k] = *(const PG8_LAS bf16x8*)(lds + PG8_SA(b, h) + aoff + m * 2048 + k * 1024); } while (0)
#define PG8_LDB(dst, b, h) do { _Pragma("unroll") for (int n = 0; n < 2; ++n) _Pragma("unroll") for (int k = 0; k < 2; ++k) dst[n][k] = *(const PG8_LAS bf16x8*)(lds + PG8_SB(b, h) + boff + n * 2048 + k * 1024); } while (0)
#define PG8_MMA(ai, bj, At, Bt) do { __builtin_amdgcn_s_setprio(1); _Pragma("unroll") for (int m = 0; m < 4; ++m) _Pragma("unroll") for (int n = 0; n < 2; ++n) _Pragma("unroll") for (int k = 0; k < 2; ++k) \
        acc[ai][bj][m][n] = __builtin_amdgcn_mfma_f32_16x16x32_bf16(Bt[n][k], At[m][k], acc[ai][bj][m][n], 0, 0, 0); __builtin_amdgcn_s_setprio(0); } while (0)
#define PG8_WAIT_V(n) asm volatile("s_waitcnt vmcnt(" #n ")" ::: "memory")
#define PG8_WAIT_L(n) asm volatile("s_waitcnt lgkmcnt(" #n ")" ::: "memory")
#define PG8_BAR __builtin_amdgcn_s_barrier()
#define PG8_SCHED __builtin_amdgcn_sched_barrier(0)
    Unit cur, nxt; int ui = 0;
    if (!S.next(0, cur)) return;
    f32x4 acc[2][2][4][2];
#pragma unroll
    for (int a = 0; a < 2; ++a)
#pragma unroll
        for (int b = 0; b < 2; ++b)
#pragma unroll
            for (int m = 0; m < 4; ++m)
#pragma unroll
                for (int n = 0; n < 2; ++n) acc[a][b][m][n] = (f32x4){0.f, 0.f, 0.f, 0.f};
    bf16x8 At[4][2], B0[2][2], B1[2][2];
    const char* cA = (const char*)g.A + (size_t)cur.pm * tstep; const char* cB = (const char*)g.Bt + (size_t)cur.pn * tstep;
    S.a_ready(cur);
    if constexpr (SP2) {
        PG8_STAGE(PG8_SB(0, 0), cB, voffB); PG8_STAGE(PG8_SB(0, 1), cB + hstep, voffB); PG8_STAGE(PG8_SA(0, 0), cA, voffA); PG8_STAGE(PG8_SA(0, 1), cA + hstep, voffA);
        if (wr == 1) PG8_BAR;
        PG8_WAIT_V(2); PG8_BAR;
        PG8_STAGE(PG8_SB(1, 0), cB + kstep, voffB); PG8_STAGE(PG8_SA(1, 0), cA + kstep, voffA); PG8_STAGE(PG8_SB(1, 1), cB + hstep + kstep, voffB);
        PG8_WAIT_V(6); PG8_BAR;
    } else {
        PG8_STAGE(PG8_SB(0, 0), cB, voffB); PG8_STAGE(PG8_SA(0, 0), cA, voffA); PG8_STAGE(PG8_SB(0, 1), cB + hstep, voffB); PG8_STAGE(PG8_SA(0, 1), cA + hstep, voffA);
        if (wr == 1) PG8_BAR;
        PG8_WAIT_V(4); PG8_BAR;
        PG8_STAGE(PG8_SB(1, 0), cB + kstep, voffB); PG8_STAGE(PG8_SA(1, 0), cA + kstep, voffA); PG8_STAGE(PG8_SB(1, 1), cB + hstep + kstep, voffB);
        PG8_WAIT_V(6); PG8_BAR;
    }
    for (;;) {
        const bool has_next = S.next(ui + 1, nxt);
        const char* nA = has_next ? (const char*)g.A + (size_t)nxt.pm * tstep : cA; const char* nB = has_next ? (const char*)g.Bt + (size_t)nxt.pn * tstep : cB;
        for (int t = 0; t < nt; t += 2) {
            const bool last = (t == nt - 2);
            const char* a1 = cA + (size_t)(t + 1) * kstep;
            const char* a2 = last ? nA : cA + (size_t)(t + 2) * kstep; const char* b2 = last ? nB : cB + (size_t)(t + 2) * kstep;
            const char* a3 = a2 + kstep; const char* b3 = b2 + kstep;
            if (last && has_next) S.a_ready(nxt);
            if constexpr (SP2) {
            PG8_LDB(B0, 0, 0); PG8_LDB(B1, 0, 1); PG8_SCHED; PG8_LDA(At, 0, 0); PG8_STAGE(PG8_SA(1, 1), a1 + hstep, voffA);
            PG8_WAIT_V(8); PG8_WAIT_L(0); PG8_BAR; PG8_MMA(0, 0, At, B0); PG8_MMA(0, 1, At, B1); PG8_BAR; PG8_SCHED;
            PG8_LDA(At, 0, 1); PG8_STAGE(PG8_SB(0, 0), b2, voffB); PG8_STAGE(PG8_SB(0, 1), b2 + hstep, voffB); PG8_STAGE(PG8_SA(0, 0), a2, voffA);
            PG8_WAIT_V(8); PG8_WAIT_L(0); PG8_BAR; PG8_MMA(1, 0, At, B0); PG8_MMA(1, 1, At, B1); PG8_BAR; PG8_SCHED;
            PG8_LDB(B0, 1, 0); PG8_LDB(B1, 1, 1); PG8_SCHED; PG8_LDA(At, 1, 0); PG8_STAGE(PG8_SA(0, 1), a2 + hstep, voffA);
            PG8_WAIT_V(8); PG8_WAIT_L(0); PG8_BAR; PG8_MMA(0, 0, At, B0); PG8_MMA(0, 1, At, B1); PG8_BAR; PG8_SCHED;
            PG8_LDA(At, 1, 1); PG8_STAGE(PG8_SB(1, 0), b3, voffB); PG8_STAGE(PG8_SB(1, 1), b3 + hstep, voffB); PG8_STAGE(PG8_SA(1, 0), a3, voffA);
            PG8_WAIT_V(8); PG8_WAIT_L(0); PG8_BAR; PG8_MMA(1, 0, At, B0); PG8_MMA(1, 1, At, B1); PG8_BAR; PG8_SCHED;
            } else {
            PG8_LDB(B0, 0, 0); PG8_SCHED; PG8_LDA(At, 0, 0); PG8_STAGE(PG8_SA(1, 1), a1 + hstep, voffA);
            PG8_WAIT_L(8); PG8_BAR; PG8_WAIT_L(0); PG8_MMA(0, 0, At, B0); PG8_BAR; PG8_SCHED;
            PG8_LDB(B1, 0, 1); PG8_STAGE(PG8_SB(0, 0), b2, voffB);
            PG8_BAR; PG8_WAIT_L(0); PG8_MMA(0, 1, At, B1); PG8_BAR;
            PG8_LDA(At, 0, 1); PG8_STAGE(PG8_SA(0, 0), a2, voffA);
            PG8_BAR; PG8_WAIT_L(0); PG8_MMA(1, 0, At, B0); PG8_BAR; PG8_SCHED;
            PG8_STAGE(PG8_SB(0, 1), b2 + hstep, voffB);
            PG8_WAIT_V(6); PG8_BAR; PG8_MMA(1, 1, At, B1); PG8_BAR;
            PG8_LDB(B0, 1, 0); PG8_SCHED; PG8_LDA(At, 1, 0); PG8_STAGE(PG8_SA(0, 1), a2 + hstep, voffA);
            PG8_WAIT_L(8); PG8_BAR; PG8_WAIT_L(0); PG8_MMA(0, 0, At, B0); PG8_BAR; PG8_SCHED;
            PG8_LDB(B1, 1, 1); PG8_STAGE(PG8_SB(1, 0), b3, voffB);
            PG8_BAR; PG8_WAIT_L(0); PG8_MMA(0, 1, At, B1); PG8_BAR;
            PG8_LDA(At, 1, 1); PG8_STAGE(PG8_SA(1, 0), a3, voffA);
            PG8_BAR; PG8_WAIT_L(0); PG8_MMA(1, 0, At, B0); PG8_BAR; PG8_SCHED;
            PG8_STAGE(PG8_SB(1, 1), b3 + hstep, voffB);
            PG8_WAIT_V(6); PG8_BAR; PG8_MMA(1, 1, At, B1); PG8_BAR;
            }
        }
        if constexpr (ALIGN_EPI) { if (wr == 0) PG8_BAR; }
        if constexpr (!Epi::AFTER_DRAIN) { E(acc, cur, wr, wc, fr, fq); S.done(cur); }
        if (!has_next) break;
#pragma unroll
        for (int a = 0; a < 2; ++a)
#pragma unroll
            for (int b = 0; b < 2; ++b)
#pragma unroll
                for (int m = 0; m < 4; ++m)
#pragma unroll
                    for (int n = 0; n < 2; ++n) acc[a][b][m][n] = (f32x4){0.f, 0.f, 0.f, 0.f};
        cur = nxt; cA = nA; cB = nB; ++ui;
        if constexpr (ALIGN_EPI) { if (wr == 1) PG8_BAR; }
    }
    PG8_WAIT_V(0);
    if constexpr (!ALIGN_EPI) { if (wr == 0) PG8_BAR; }
    PG8_BAR;
    if constexpr (Epi::AFTER_DRAIN) { E.fused(acc, cur, wr, wc, fr, fq, lds, wid, lane); S.done(cur); }
#undef PG8_SA
#undef PG8_SB
#undef PG8_STAGE
#undef PG8_LDA
#undef PG8_LDB
#undef PG8_MMA
#undef PG8_WAIT_V
#undef PG8_WAIT_L
#undef PG8_BAR
#undef PG8_SCHED
}
}

constexpr int NB = 2, T = 16384, M = NB * T, D = 2048, FF = 5632, NIN = 6456, NINP = 6656, DEPTH = 2, MODW = 9 * D;
constexpr int ZQ = 0, ZKC = 1024, ZVC = 1280, ZKS = 1536, ZVS = 1792, ZKW = 2048, ZVW = 2304, ZGT = 2560;
constexpr int ZMQ = 2608, ZMK = 3120, ZMV = 3632, ZMO = 4144, ZMI = 4656, ZMF = 4660;
constexpr int ZRW = 4664, RWC = 1792;
constexpr int YML = 1024, YRW = 1536;
constexpr int NWAVES = 8, NTHREADS = 512;

constexpr size_t MiB = (size_t)1 << 20;
constexpr size_t WS_CTL = 0, CTL_ZERO_BYTES = 64 * 1024;
constexpr size_t WS_MOD = 1 * MiB;
constexpr size_t WS_KC = 2 * MiB, WS_VC = 3 * MiB;
constexpr size_t WS_MLF = 4 * MiB;
constexpr size_t WS_MLI = 4 * MiB + 512 * 1024;
constexpr size_t WS_MLG = 5 * MiB;
constexpr size_t WS_MLNP = 6 * MiB;
constexpr size_t WS_MLNS = 7 * MiB;
constexpr size_t WS_WGU = 10 * MiB;
constexpr size_t WS_WD = 186 * MiB;
constexpr size_t WS_WIN = 274 * MiB;
constexpr size_t WS_WOUT = 326 * MiB;
constexpr size_t WS_H = 342 * MiB;
constexpr size_t WS_ZA = 470 * MiB;
constexpr size_t WS_MIX = 886 * MiB;
constexpr size_t WS_END = 1142 * MiB;
constexpr size_t MX_RR = 0, MX_RK = 32 * MiB, MX_RV = 64 * MiB, MX_RN = 96 * MiB, MX_RA = 128 * MiB, MX_RWW = 160 * MiB;
constexpr size_t MX_MQ = 0, MX_MK = 32 * MiB, MX_U = 64 * MiB, MX_CT = 192 * MiB;

constexpr int CW_BAR = 1024;

#define GAS __attribute__((address_space(1)))
#define LAS __attribute__((address_space(3)))
typedef unsigned short bf16;
typedef float f32x4 __attribute__((ext_vector_type(4)));
typedef float f32x2 __attribute__((ext_vector_type(2)));
typedef unsigned v4u __attribute__((ext_vector_type(4)));
typedef unsigned v2u __attribute__((ext_vector_type(2)));
__device__ __forceinline__ float bf2f(unsigned short b) { return __uint_as_float(((unsigned)b) << 16); }
__device__ __forceinline__ float bflo(unsigned w) { return __uint_as_float(w << 16); }
__device__ __forceinline__ float bfhi(unsigned w) { return __uint_as_float(w & 0xffff0000u); }
__device__ __forceinline__ unsigned f2bf(float f) { unsigned u = __float_as_uint(f); return (u + 0x7fffu + ((u >> 16) & 1u)) >> 16; }
__device__ __forceinline__ unsigned pk2(float lo, float hi) { return f2bf(lo) | (f2bf(hi) << 16); }
template <int CTRL> __device__ __forceinline__ float dpp_mov(float v) { return __int_as_float(__builtin_amdgcn_update_dpp(0, __float_as_int(v), CTRL, 0xF, 0xF, false)); }
__device__ __forceinline__ float rdlane(float v, int l) { return __int_as_float(__builtin_amdgcn_readlane(__float_as_int(v), l)); }
__device__ __forceinline__ float wave_sum(float v) {
    v += dpp_mov<0xB1>(v); v += dpp_mov<0x4E>(v); v += dpp_mov<0x141>(v); v += dpp_mov<0x140>(v);
    return (rdlane(v, 0) + rdlane(v, 16)) + (rdlane(v, 32) + rdlane(v, 48));
}
__device__ __forceinline__ float wave_max(float v) {
    v = fmaxf(v, dpp_mov<0xB1>(v)); v = fmaxf(v, dpp_mov<0x4E>(v)); v = fmaxf(v, dpp_mov<0x141>(v)); v = fmaxf(v, dpp_mov<0x140>(v));
    return fmaxf(fmaxf(rdlane(v, 0), rdlane(v, 16)), fmaxf(rdlane(v, 32), rdlane(v, 48)));
}
__device__ __forceinline__ float swz16(float v) { return __int_as_float(__builtin_amdgcn_ds_swizzle(__float_as_int(v), 0x401F)); }
__device__ __forceinline__ int swz16i(int v) { return __builtin_amdgcn_ds_swizzle(v, 0x401F); }
__device__ __forceinline__ int opq(int x) { asm volatile("" : "+v"(x)); return x; }
__device__ __forceinline__ unsigned cvtpk(float lo, float hi) { unsigned r; asm volatile("v_cvt_pk_bf16_f32 %0, %1, %2" : "=v"(r) : "v"(lo), "v"(hi)); return r; }
typedef short bf16x8 __attribute__((ext_vector_type(8)));
#define MFMA16(a, b, c) __builtin_amdgcn_mfma_f32_16x16x32_bf16((a), (b), (c), 0, 0, 0)
__device__ __forceinline__ float xmax4(float x) { const auto s = __builtin_amdgcn_permlane16_swap(__float_as_uint(x), __float_as_uint(x), false, false); x = fmaxf(__uint_as_float(s[0]), __uint_as_float(s[1]));
    const auto t = __builtin_amdgcn_permlane32_swap(__float_as_uint(x), __float_as_uint(x), false, false); return fmaxf(__uint_as_float(t[0]), __uint_as_float(t[1])); }
__device__ __forceinline__ float xsum4(float x) { const auto s = __builtin_amdgcn_permlane16_swap(__float_as_uint(x), __float_as_uint(x), false, false); x = __uint_as_float(s[0]) + __uint_as_float(s[1]);
    const auto t = __builtin_amdgcn_permlane32_swap(__float_as_uint(x), __float_as_uint(x), false, false); return __uint_as_float(t[0]) + __uint_as_float(t[1]); }
__device__ __forceinline__ float bperm(float v, int srclane) { return __int_as_float(__builtin_amdgcn_ds_bpermute(srclane << 2, __float_as_int(v))); }
__device__ __forceinline__ float wave_prefix_sum(float v, int lane) {
#pragma unroll
    for (int d = 1; d < 64; d <<= 1) { const float o = bperm(v, (lane - d) & 63); if (lane >= d) v += o; }
    return v; }
__device__ __forceinline__ float wave_prefix_max(float v, int lane) {
#pragma unroll
    for (int d = 1; d < 64; d <<= 1) { const float o = bperm(v, (lane - d) & 63); if (lane >= d) v = fmaxf(v, o); }
    return v; }
__device__ __forceinline__ float sigmoidf_(float x) { return __builtin_amdgcn_rcpf(1.0f + __expf(-x)); }
__device__ __forceinline__ float siluf_(float x) { return x * __builtin_amdgcn_rcpf(1.0f + __expf(-x)); }
__device__ __forceinline__ float logsigmoidf_(float x) { return fminf(x, 0.f) - __logf(1.0f + __expf(-fabsf(x))); }
__device__ __forceinline__ float softplusf_(float x) { return fmaxf(x, 0.f) + __logf(1.0f + __expf(-fabsf(x))); }

#define XB_TMO      128
#define XB_XCNT(j)  (256  + 64 * (j))
#define XB_XSUB(j)  (1280 + 64 * (j))
#define XB_XGEN(j)  (2304 + 64 * (j))
#define XB_TOP      3328
#define XB_TOPGEN   3392
#define XCD_BAR_WORDS 3456
#define XB_SPIN_CAP (1u << 18)
__device__ __forceinline__ unsigned xb_ld(unsigned* p)              { return __hip_atomic_load(p, __ATOMIC_RELAXED, __HIP_MEMORY_SCOPE_AGENT); }
__device__ __forceinline__ unsigned xb_add(unsigned* p, unsigned v) { return __hip_atomic_fetch_add(p, v, __ATOMIC_RELAXED, __HIP_MEMORY_SCOPE_AGENT); }
__device__ __forceinline__ unsigned xb_xcc_id() { return (unsigned)__builtin_amdgcn_s_getreg((3 << 11) | 20) & 0xFu; }
#define XB_SPIN(cond, bar) do { unsigned _sp = 0; while (cond) { __builtin_amdgcn_s_sleep(1); \
    if ((++_sp & 255u) == 0u) { if (xb_ld(&(bar)[XB_TMO])) break; if (_sp > XB_SPIN_CAP) { atomicAdd(&(bar)[XB_TMO], 1u); break; } } } } while (0)
struct XcdBarrier { unsigned* bar; unsigned x; volatile LAS unsigned* st; };
__device__ __forceinline__ XcdBarrier xcd_barrier_post(unsigned* bar, volatile LAS unsigned* st, int tid) {
    XcdBarrier b; b.bar = bar; b.x = xb_xcc_id(); b.st = st;
    if (tid == 0) (void)xb_add(&bar[XB_XCNT(b.x)], 1u);
    return b;
}
__device__ __forceinline__ void xcd_barrier_complete(unsigned* bar, unsigned x, unsigned& nloc, unsigned& nx) {
    const unsigned G = gridDim.x * gridDim.y * gridDim.z;
    unsigned sum, cnt, mine, sp = 0u;
    for (;;) {
        sum = 0u; cnt = 0u; mine = 0u;
#pragma unroll
        for (unsigned j = 0; j < 16; ++j) { const unsigned c = xb_ld(&bar[XB_XCNT(j)]); sum += c; cnt += (c > 0u) ? 1u : 0u; mine = (j == x) ? c : mine; }
        if (sum == G) break;
        __builtin_amdgcn_s_sleep(1);
        if ((++sp & 255u) == 0u) { if (xb_ld(&bar[XB_TMO])) break; if (sp > XB_SPIN_CAP) { atomicAdd(&bar[XB_TMO], 1u); break; } }
    }
    nloc = mine > 0u ? mine : 1u; nx = cnt > 0u ? cnt : 1u;
}
__device__ __forceinline__ void xcd_barrier(const XcdBarrier& b, int tid) {
    asm volatile("s_waitcnt vmcnt(0)" ::: "memory");
    __syncthreads();
    if (tid == 0) {
        unsigned* bar = b.bar;
        __builtin_amdgcn_s_waitcnt(0);
        unsigned nloc = b.st[0], nx = b.st[1];
        if (nloc == 0u) { xcd_barrier_complete(bar, b.x, nloc, nx); b.st[0] = nloc; b.st[1] = nx; }
        const unsigned old = xb_add(&bar[XB_XSUB(b.x)], 1u);
        const unsigned gen = old / nloc;
        if (old + 1u == (gen + 1u) * nloc) {
            __builtin_amdgcn_fence(__ATOMIC_RELEASE, "agent");
            asm volatile("s_waitcnt vmcnt(0)" ::: "memory");
            const unsigned og = xb_add(&bar[XB_TOP], 1u);
            const unsigned tg = og / nx;
            if (og + 1u == (tg + 1u) * nx) xb_add(&bar[XB_TOPGEN], 1u);
            else XB_SPIN(xb_ld(&bar[XB_TOPGEN]) == tg, bar);
            __builtin_amdgcn_fence(__ATOMIC_ACQUIRE, "agent");
            xb_add(&bar[XB_XGEN(b.x)], 1u);
            asm volatile("s_waitcnt vmcnt(0)" ::: "memory");
        } else {
            XB_SPIN(xb_ld(&bar[XB_XGEN(b.x)]) == gen, bar);
            __builtin_amdgcn_fence(__ATOMIC_ACQUIRE, "agent");
            asm volatile("s_waitcnt vmcnt(0)" ::: "memory");
        }
    }
    __syncthreads();
}

constexpr int LDS_BYTES = 163328;
constexpr int LDS_MISC = 163328 - 512;
struct Args { const float* in[29]; float* out; unsigned char* ws; int lo, hi, use_bar, pad; };
struct Frame {
    LAS unsigned char* lds; int tid, lane, wave, G, bid;
    const LAS unsigned long long* inl; float* out; unsigned char* ws;
    __device__ __forceinline__ const float* inp(int i) const { const unsigned long long v = inl[i];
        const unsigned lo = __builtin_amdgcn_readfirstlane((unsigned)v), hi = __builtin_amdgcn_readfirstlane((unsigned)(v >> 32));
        return (const float*)(((unsigned long long)hi << 32) | lo); }
};
#define LDS_WAIT() asm volatile("s_waitcnt lgkmcnt(0)" ::: "memory")
__device__ __forceinline__ int lane_id_fresh() { int l; asm volatile("v_mbcnt_lo_u32_b32 %0, -1, 0\n\tv_mbcnt_hi_u32_b32 %0, -1, %0" : "=v"(l)); return l; }

__device__ __forceinline__ void tr_item(const float* W, int K, int N, bf16* WT, int dst_row0, int k0, int n0, LAS float* scr, int lane) {
#pragma unroll
    for (int i = 0; i < 8; ++i) { const int kk = 8 * i + (lane >> 3), nl = (lane & 7) * 4, n = n0 + nl;
        f32x4 w = {0.f, 0.f, 0.f, 0.f}; if (n < N) w = *(const f32x4*)(W + (size_t)(k0 + kk) * N + n);
        LAS float* d = scr + kk * 33 + nl; d[0] = w.x; d[1] = w.y; d[2] = w.z; d[3] = w.w; }
    LDS_WAIT(); asm volatile("" ::: "memory");
    const int c = lane & 7;
#pragma unroll
    for (int j = 0; j < 4; ++j) { const int n = (lane >> 3) + 8 * j; const LAS float* s = scr + (8 * c) * 33 + n;
        v4u o; o.x = cvtpk(s[0 * 33], s[1 * 33]); o.y = cvtpk(s[2 * 33], s[3 * 33]); o.z = cvtpk(s[4 * 33], s[5 * 33]); o.w = cvtpk(s[6 * 33], s[7 * 33]);
        *(v4u*)(WT + (size_t)(dst_row0 + n) * K + k0 + 8 * c) = o; }
    LDS_WAIT(); asm volatile("" ::: "memory");
}
struct TrJob { const float* W; bf16* WT; int K, N, dst_row0, k0, n0; };
__device__ __forceinline__ void tr_load(const TrJob& j, int lane, f32x4 (&w)[8]) {
#pragma unroll
    for (int i = 0; i < 8; ++i) { const int kk = 8 * i + (lane >> 3), n = j.n0 + (lane & 7) * 4; w[i] = (f32x4){0.f, 0.f, 0.f, 0.f}; if (n < j.N) w[i] = *(const f32x4*)(j.W + (size_t)(j.k0 + kk) * j.N + n); }
}
__device__ __forceinline__ void tr_finish(const TrJob& j, const f32x4 (&w)[8], LAS float* scr, int lane) {
#pragma unroll
    for (int i = 0; i < 8; ++i) { const int kk = 8 * i + (lane >> 3), nl = (lane & 7) * 4; LAS float* d = scr + kk * 33 + nl; d[0] = w[i].x; d[1] = w[i].y; d[2] = w[i].z; d[3] = w[i].w; }
    LDS_WAIT(); asm volatile("" ::: "memory");
    const int c = lane & 7;
#pragma unroll
    for (int q = 0; q < 4; ++q) { const int n = (lane >> 3) + 8 * q; const LAS float* sp = scr + (8 * c) * 33 + n;
        v4u o; o.x = cvtpk(sp[0 * 33], sp[1 * 33]); o.y = cvtpk(sp[2 * 33], sp[3 * 33]); o.z = cvtpk(sp[4 * 33], sp[5 * 33]); o.w = cvtpk(sp[6 * 33], sp[7 * 33]);
        *(v4u*)(j.WT + (size_t)(j.dst_row0 + n) * j.K + j.k0 + 8 * c) = o; }
    LDS_WAIT(); asm volatile("" ::: "memory");
}
constexpr int WC_IG = (D / 64) * (FF / 32), WC_ID = (FF / 64) * (D / 32), WC_IIN = (D / 64) * (NINP / 32), WC_IOUT = (D / 64) * (D / 32);
constexpr int WC_NEARLY = 2 * WC_IG + WC_ID + WC_IIN, WC_NDEFER = 6 * WC_IG + 3 * WC_ID + WC_IIN + 2 * WC_IOUT;
__device__ __forceinline__ void wconv_item(Frame& F, int it, LAS float* scr, int lane) {
    constexpr int I_G = WC_IG, I_D = WC_ID, I_IN = WC_IIN, I_OUT = WC_IOUT;
    bf16* WGU = (bf16*)(F.ws + WS_WGU); bf16* WD = (bf16*)(F.ws + WS_WD); bf16* WIN = (bf16*)(F.ws + WS_WIN); bf16* WOUT = (bf16*)(F.ws + WS_WOUT);
    int r = it;
    if (r < 8 * I_G) {
        const int mat = r / I_G, ls = mat & 3, isup = mat >> 2; r -= mat * I_G;
        const int nblk = FF / 32, kb = r / nblk, nb = r % nblk, n0 = 32 * nb;
        const float* W = (isup ? F.inp(8) : F.inp(7)) + (size_t)ls * D * FF;
        tr_item(W, D, FF, WGU + (size_t)ls * 2 * FF * D, (n0 / 128) * 256 + (n0 % 128) + isup * 128, 64 * kb, n0, scr, lane);
        return; }
    r -= 8 * I_G;
    if (r < 4 * I_D) { const int ls = r / I_D; r -= ls * I_D; const int nblk = D / 32, kb = r / nblk, nb = r % nblk;
        tr_item(F.inp(9) + (size_t)ls * FF * D, FF, D, WD + (size_t)ls * D * FF, 32 * nb, 64 * kb, 32 * nb, scr, lane); return; }
    r -= 4 * I_D;
    if (r < 2 * I_IN) { const int l = r / I_IN; r -= l * I_IN; const int nblk = NINP / 32, kb = r / nblk, nb = r % nblk;
        tr_item(F.inp(10) + (size_t)l * D * NIN, D, NIN, WIN + (size_t)l * NINP * D, 32 * nb, 64 * kb, 32 * nb, scr, lane); return; }
    r -= 2 * I_IN;
    { const int l = r / I_OUT; r -= l * I_OUT; const int nblk = D / 32, kb = r / nblk, nb = r % nblk;
        tr_item(F.inp(11) + (size_t)l * D * D, D, D, WOUT + (size_t)l * D * D, 32 * nb, 64 * kb, 32 * nb, scr, lane); }
}
__device__ __forceinline__ TrJob wconv_job(Frame& F, int it) {
    constexpr int I_G = WC_IG, I_D = WC_ID, I_IN = WC_IIN, I_OUT = WC_IOUT;
    bf16* WGU = (bf16*)(F.ws + WS_WGU); bf16* WD = (bf16*)(F.ws + WS_WD); bf16* WIN = (bf16*)(F.ws + WS_WIN); bf16* WOUT = (bf16*)(F.ws + WS_WOUT);
    int r = it;
    if (r < 8 * I_G) { const int mat = r / I_G, ls = mat & 3, isup = mat >> 2; r -= mat * I_G;
        const int nblk = FF / 32, kb = r / nblk, nb = r % nblk, n0 = 32 * nb;
        return TrJob{(isup ? F.inp(8) : F.inp(7)) + (size_t)ls * D * FF, WGU + (size_t)ls * 2 * FF * D, D, FF, (n0 / 128) * 256 + (n0 % 128) + isup * 128, 64 * kb, n0}; }
    r -= 8 * I_G;
    if (r < 4 * I_D) { const int ls = r / I_D; r -= ls * I_D; const int nblk = D / 32, kb = r / nblk, nb = r % nblk;
        return TrJob{F.inp(9) + (size_t)ls * FF * D, WD + (size_t)ls * D * FF, FF, D, 32 * nb, 64 * kb, 32 * nb}; }
    r -= 4 * I_D;
    if (r < 2 * I_IN) { const int l = r / I_IN; r -= l * I_IN; const int nblk = NINP / 32, kb = r / nblk, nb = r % nblk;
        return TrJob{F.inp(10) + (size_t)l * D * NIN, WIN + (size_t)l * NINP * D, D, NIN, 32 * nb, 64 * kb, 32 * nb}; }
    r -= 2 * I_IN;
    { const int l = r / I_OUT; r -= l * I_OUT; const int nblk = D / 32, kb = r / nblk, nb = r % nblk;
        return TrJob{F.inp(11) + (size_t)l * D * D, WOUT + (size_t)l * D * D, D, D, 32 * nb, 64 * kb, 32 * nb}; }
}
__device__ __forceinline__ int wconv_early(int e) {
    if (e < WC_IG) return e;
    if (e < 2 * WC_IG) return 4 * WC_IG + (e - WC_IG);
    if (e < 2 * WC_IG + WC_ID) return 8 * WC_IG + (e - 2 * WC_IG);
    return 8 * WC_IG + 4 * WC_ID + (e - 2 * WC_IG - WC_ID);
}
constexpr int WC_NDEFER0 = 4 * WC_IG + 2 * WC_ID + WC_IIN + WC_IOUT, WC_NDEFER1 = 2 * WC_IG + WC_ID + WC_IOUT;
static_assert(WC_NDEFER0 + WC_NDEFER1 == WC_NDEFER, "deferred lots");
__device__ __forceinline__ int wconv_deferred(int lot, int d) {
    if (lot == 0) {
        if (d < 4 * WC_IG) { const int m4 = d / WC_IG; const int mat = (m4 < 2) ? m4 + 1 : m4 + 3; return mat * WC_IG + (d - m4 * WC_IG); }
        d -= 4 * WC_IG;
        if (d < 2 * WC_ID) return 8 * WC_IG + WC_ID + d;
        d -= 2 * WC_ID;
        if (d < WC_IIN) return 8 * WC_IG + 4 * WC_ID + WC_IIN + d;
        d -= WC_IIN;
        return 8 * WC_IG + 4 * WC_ID + 2 * WC_IIN + d;
    }
    if (d < 2 * WC_IG) { const int m2 = d / WC_IG; const int mat = m2 ? 7 : 3; return mat * WC_IG + (d - m2 * WC_IG); }
    d -= 2 * WC_IG;
    if (d < WC_ID) return 8 * WC_IG + 3 * WC_ID + d;
    d -= WC_ID;
    return 8 * WC_IG + 4 * WC_ID + 2 * WC_IIN + WC_IOUT + d;
}
__device__ __forceinline__ void ph_prologue(Frame& F) {
    LAS float* scr = (LAS float*)(F.lds + F.wave * 16384);
    const int gw = F.bid * NWAVES + F.wave, NGW = F.G * NWAVES;
    {   int e = gw; f32x4 wv[8]; TrJob jb{}; bool have = e < WC_NEARLY;
        if (have) { jb = wconv_job(F, wconv_early(e)); tr_load(jb, F.lane, wv); }
        while (have) { const int en = e + NGW; const bool haven = en < WC_NEARLY; f32x4 wn[8]; TrJob jn = jb;
            if (haven) { jn = wconv_job(F, wconv_early(en)); tr_load(jn, F.lane, wn); }
            tr_finish(jb, wv, scr, F.lane);
            if (haven) {
#pragma unroll
                for (int i = 0; i < 8; ++i) wv[i] = wn[i]; }
            jb = jn; e = en; have = haven; } }
    {
        unsigned char* sw = F.ws + (size_t)1174 * MiB;
        constexpr int NS = 2 * (16 + 16 + 32) + 4 * 128 + 4 * 4;
        for (int it = gw; it < NS; it += NGW) {
            int r = it;
            if (r < 128) { const int l = r / 64; r -= l * 64;
                if (r < 16) tr_item(F.inp(21) + (size_t)l * 64 * 512, 64, 512, (bf16*)sw + (size_t)l * 512 * 64, 32 * r, 0, 32 * r, scr, F.lane);
                else if (r < 32) { r -= 16; tr_item(F.inp(23) + (size_t)l * 64 * 512, 64, 512, (bf16*)(sw + 128 * 1024) + (size_t)l * 512 * 64, 32 * r, 0, 32 * r, scr, F.lane); }
                else { r -= 32; tr_item(F.inp(24) + (size_t)l * 128 * 512, 128, 512, (bf16*)(sw + 256 * 1024) + (size_t)l * 512 * 128, 32 * (r & 15), 64 * (r >> 4), 32 * (r & 15), scr, F.lane); }
                continue; }
            r -= 128;
            if (r < 512) { const int lk = r / 128; r -= lk * 128; tr_item(F.inp(13) + (size_t)lk * 2048 * 128, 2048, 128, (bf16*)(sw + 512 * 1024) + (size_t)lk * 128 * 2048, 32 * (r & 3), 64 * (r >> 2), 32 * (r & 3), scr, F.lane); continue; }
            r -= 512;
            { const int lk = r / 4; r -= lk * 4; tr_item(F.inp(14) + (size_t)lk * 128 * 64, 128, 64, (bf16*)(sw + 512 * 1024 + 4 * 512 * 1024) + (size_t)lk * 64 * 128, 32 * (r & 1), 64 * (r >> 1), 32 * (r & 1), scr, F.lane); }
        }
    }
    __syncthreads();
    if (F.bid < 4) {
        LAS float* red = (LAS float*)F.lds; const int lk = F.bid, j = F.tid & 127, part = F.tid >> 7;
        const float* w1 = F.inp(13) + (size_t)lk * 2048 * 128; const float* pos = F.inp(12) + (size_t)lk * 2048; float s = 0.f;
        for (int kk = 0; kk < 512; ++kk) { const int k = part * 512 + kk; s += pos[k] * w1[(size_t)k * 128 + j]; }
        red[part * 128 + j] = s; __syncthreads();
        if (F.tid < 128) ((float*)(F.ws + (size_t)1179 * MiB))[lk * 128 + j] = red[j] + red[128 + j] + red[256 + j] + red[384 + j];
        __syncthreads();
    }
    {
        float* mod = (float*)(F.ws + WS_MOD);
        LAS f32x4* red = (LAS f32x4*)F.lds;
        const int tx = F.tid & 15, ty = F.tid >> 4;
        for (int it = F.bid; it < DEPTH * (MODW / 64); it += F.G) {
            const int l = it / (MODW / 64), n0 = (it % (MODW / 64)) * 64 + 4 * tx;
            const float* W = F.inp(4) + (size_t)l * D * MODW + n0;
            f32x4 a0 = {0.f, 0.f, 0.f, 0.f}, a1 = {0.f, 0.f, 0.f, 0.f};
            for (int kk = 0; kk < 64; ++kk) { const int k = ty * 64 + kk; const f32x4 w = *(const f32x4*)(W + (size_t)k * MODW);
                const float c0 = siluf_(F.inp(1)[k]), c1 = siluf_(F.inp(1)[D + k]); a0 += w * c0; a1 += w * c1; }
            red[(ty * 16 + tx) * 2 + 0] = a0; red[(ty * 16 + tx) * 2 + 1] = a1;
            __syncthreads();
            if (F.tid < 128) { const int b = F.tid >> 6, col = F.tid & 63; float s = 0.f;
                for (int y = 0; y < 32; ++y) s += red[(y * 16 + (col >> 2)) * 2 + b][col & 3];
                const int n = (it % (MODW / 64)) * 64 + col;
                mod[((size_t)l * NB + b) * MODW + n] = s + F.inp(5)[(size_t)l * MODW + n]; }
            __syncthreads();
        }
    }
}

template <bool DELTA> __device__ __forceinline__ void ph_adaln(Frame& F, const float* xin, const bf16* dl, int l, int sub) {
    LAS float* A = (LAS float*)F.lds; LAS float* Bv = A + NB * D;
    const float* mod = (const float*)(F.ws + WS_MOD) + (size_t)l * NB * MODW;
    const float* g = F.inp(6) + ((size_t)l * 3 + sub) * D;
    for (int i = F.tid; i < NB * D; i += NTHREADS) { const int b = i / D, d = i % D;
        A[i] = g[d] * (1.0f + mod[(size_t)b * MODW + (sub * 3 + 1) * D + d]); Bv[i] = mod[(size_t)b * MODW + (sub * 3 + 0) * D + d]; }
    __syncthreads();
    bf16* H = (bf16*)(F.ws + WS_H);
    const int gw = F.bid * NWAVES + F.wave, NGW = F.G * NWAVES;
    for (int m = gw; m < M; m += NGW) {
        const int b = m / T;
        const f32x4* xr = (const f32x4*)(xin + (size_t)m * D) + F.lane;
        f32x4 v[8]; float ss = 0.f;
#pragma unroll
        for (int j = 0; j < 8; ++j) v[j] = __builtin_nontemporal_load(&xr[64 * j]);
        if (DELTA) { const v2u* dr = (const v2u*)(dl + (size_t)m * D) + F.lane; f32x4* xo = (f32x4*)(F.out + (size_t)m * D) + F.lane;
#pragma unroll
            for (int j = 0; j < 8; ++j) { const v2u w = dr[64 * j]; v[j] += (f32x4){bflo(w.x), bfhi(w.x), bflo(w.y), bfhi(w.y)}; __builtin_nontemporal_store(v[j], &xo[64 * j]); } }
#pragma unroll
        for (int j = 0; j < 8; ++j) ss += (v[j].x * v[j].x + v[j].y * v[j].y) + (v[j].z * v[j].z + v[j].w * v[j].w);
        const float rstd = 1.0f / sqrtf(wave_sum(ss) * (1.0f / D) + 1e-6f);
        v2u* o8 = (v2u*)(H + (size_t)m * D) + F.lane;
#pragma unroll
        for (int j = 0; j < 8; ++j) { const int e = b * D + 4 * F.lane + 256 * j; const f32x4 a = *(const LAS f32x4*)(A + e), s = *(const LAS f32x4*)(Bv + e);
            const f32x4 y = v[j] * rstd * a + s; v2u w; w.x = pk2(y.x, y.y); w.y = pk2(y.z, y.w); o8[64 * j] = w; }
    }
    __syncthreads();
}
__device__ __forceinline__ void ph_final(Frame& F) {
    const float* g = F.inp(3);
    const int gw = F.bid * NWAVES + F.wave, NGW = F.G * NWAVES;
    for (int m = gw; m < M; m += NGW) {
        f32x4* xr = (f32x4*)(F.out + (size_t)m * D) + F.lane;
        const v2u* dr = (const v2u*)((const bf16*)(F.ws + WS_H) + (size_t)m * D) + F.lane;
        f32x4 v[8]; float ss = 0.f;
#pragma unroll
        for (int j = 0; j < 8; ++j) { const v2u w = dr[64 * j]; v[j] = xr[64 * j] + (f32x4){bflo(w.x), bfhi(w.x), bflo(w.y), bfhi(w.y)}; ss += (v[j].x * v[j].x + v[j].y * v[j].y) + (v[j].z * v[j].z + v[j].w * v[j].w); }
        const float rstd = 1.0f / sqrtf(wave_sum(ss) * (1.0f / D) + 1e-6f);
#pragma unroll
        for (int j = 0; j < 8; ++j) { const f32x4 gg = *((const f32x4*)g + F.lane + 64 * j); xr[64 * j] = v[j] * rstd * gg; }
    }
}

__device__ __forceinline__ int rel_bucket_dev(int d) {
    if (d < 16) return d;
    const int large = 16 + (int)(logf((float)d * (1.0f / 16.0f)) / 2.0794415416798357f * 16.0f);
    return large < 31 ? large : 31;
}

__device__ __forceinline__ void ph_compress(Frame& F, int l) {
    const bf16* Z = (const bf16*)(F.ws + WS_ZA);
    LAS float* tok = (LAS float*)F.lds;
    LAS float* red = tok + 144 * 64;
    LAS float* hid = red + 4 * 8 * 128;
    const int j = F.tid & 127, part = F.tid >> 7;
    for (int it = F.bid; it < 2 * NB * 4 * 128; it += F.G) {
        const int grp = it & 127, kvh = (it >> 7) & 3, b = (it >> 9) & 1, kv = it >> 10;
        const int t0 = grp * 128;
        const bf16* zc = Z + (size_t)(b * T) * NINP + (kv ? ZVC : ZKC) + kvh * 64;
        for (int i = F.tid; i < 144 * 64; i += NTHREADS) { const int tt = t0 + (i >> 6); tok[i] = (tt < T) ? bf2f(zc[(size_t)tt * NINP + (i & 63)]) : 0.f; }
        __syncthreads();
        const float* w1 = F.inp(13) + ((size_t)l * 2 + kv) * 2048 * 128;
        const float* pos = F.inp(12) + ((size_t)l * 2 + kv) * 32 * 64;
        float acc[8], accp = 0.f;
#pragma unroll
        for (int i = 0; i < 8; ++i) acc[i] = 0.f;
        for (int kk = 0; kk < 512; ++kk) { const int k = part * 512 + kk, r = k >> 6, d = k & 63; const float w = w1[(size_t)k * 128 + j];
            accp += pos[k] * w;
#pragma unroll
            for (int i = 0; i < 8; ++i) acc[i] += tok[(16 * i + r) * 64 + d] * w; }
#pragma unroll
        for (int i = 0; i < 8; ++i) red[(part * 8 + i) * 128 + j] = acc[i] + accp;
        __syncthreads();
        for (int i = F.tid; i < 8 * 128; i += NTHREADS) { const float s = red[i] + red[1024 + i] + red[2048 + i] + red[3072 + i]; hid[i] = siluf_(s); }
        __syncthreads();
        { const int ii = F.tid >> 6, d = F.tid & 63; const float* w2 = F.inp(14) + ((size_t)l * 2 + kv) * 128 * 64; float s = 0.f;
          for (int q = 0; q < 128; ++q) s += hid[ii * 128 + q] * w2[q * 64 + d];
          if (kv) ((bf16*)(F.ws + WS_VC))[((size_t)(b * 4 + kvh) * 64 + d) * 1024 + grp * 8 + ii] = (bf16)f2bf(s);
          else ((bf16*)(F.ws + WS_KC))[((size_t)(b * 4 + kvh) * 1024 + grp * 8 + ii) * 64 + d] = (bf16)f2bf(s); }
        __syncthreads();
    }
}

template <int MODE> __device__ __forceinline__ void ph_rwkv_tok(Frame& F, int l) {
    const bf16* Z = (const bf16*)(F.ws + WS_ZA);
    LAS float* zs = (LAS float*)F.lds;
    LAS float* th = zs + RWC;
    LAS float* sg = th + 64;
    const float* mu = F.inp(19) + (size_t)l * RWC; const float* w0 = F.inp(20) + (size_t)l * 512; const float* w_up = F.inp(21) + (size_t)l * 64 * 512;
    const float* a0 = F.inp(22) + (size_t)l * 512; const float* a_up = F.inp(23) + (size_t)l * 64 * 512; const float* g_up = F.inp(24) + (size_t)l * 128 * 512;
    const float* k_k = F.inp(25) + (size_t)l * 512; const float* k_a = F.inp(26) + (size_t)l * 512; const float* r_k = F.inp(27) + (size_t)l * 512;
    const float* ln0 = F.inp(28) + (size_t)l * 2 * 512; const float* ln1 = ln0 + 512;
    unsigned char* mx = F.ws + WS_MIX;
    bf16* RR = (bf16*)(mx + MX_RR); bf16* RK = (bf16*)(mx + MX_RK); bf16* RV = (bf16*)(mx + MX_RV); bf16* RN = (bf16*)(mx + MX_RN); bf16* RA = (bf16*)(mx + MX_RA); float* RW = (float*)(mx + MX_RWW);
    bf16* Y = (bf16*)(F.ws + WS_H);
    const int c = F.tid;
    for (int m = F.bid; m < M; m += F.G) {
        const int t = m % T;
        const bf16* zr = Z + (size_t)m * NINP + ZRW;
        for (int i = F.tid; i < RWC; i += NTHREADS) { const float zc = bf2f(zr[i]); const float zp = (t > 0) ? bf2f(zr[i - NINP]) : 0.f; zs[i] = zc + mu[i] * (zp - zc); }
        __syncthreads();
        if (F.tid < 64) th[F.tid] = tanhf(zs[1536 + F.tid]);
        else if (F.tid < 192) sg[F.tid - 64] = sigmoidf_(zs[1664 + F.tid - 64]);
        __syncthreads();
        const float r = zs[c], k = zs[512 + c], v = zs[1024 + c];
        float ws_ = w0[c], as_ = a0[c];
        for (int q = 0; q < 64; ++q) { ws_ += th[q] * w_up[q * 512 + c]; as_ += zs[1600 + q] * a_up[q * 512 + c]; }
        const float a = sigmoidf_(as_);
        const float kp = k * (1.0f + (a - 1.0f) * k_a[c]);
        if (MODE == 0) {
            const float w_log = -softplusf_(-ws_) - 0.5f; const float decay = expf(-expf(w_log));
            float kk = k * k_k[c]; const float nrm = sqrtf(wave_sum(kk * kk)); kk = kk / fmaxf(nrm, 1e-12f);
            const size_t o = (size_t)m * 512 + c;
            RR[o] = (bf16)f2bf(r); RK[o] = (bf16)f2bf(kp); RV[o] = (bf16)f2bf(v); RN[o] = (bf16)f2bf(kk); RA[o] = (bf16)f2bf(a); RW[o] = decay;
        } else {
            float g = 0.f;
            for (int q = 0; q < 128; ++q) g += sg[q] * g_up[q * 512 + c];
            const float rb = bf2f((bf16)f2bf(r)), kb = bf2f((bf16)f2bf(kp)), vb = bf2f((bf16)f2bf(v));
            const float bonus = wave_sum(rb * kb * r_k[c]);
            const float y = bf2f(Y[(size_t)m * D + YRW + c]);
            const float mu_ = wave_sum(y) * (1.0f / 64.0f); const float dy = y - mu_; const float var = wave_sum(dy * dy) * (1.0f / 64.0f);
            float o = dy * (1.0f / sqrtf(var + 64e-5f)) * ln0[c] + ln1[c];
            o += bonus * vb;
            Y[(size_t)m * D + YRW + c] = (bf16)f2bf(o * g);
        }
        __syncthreads();
    }
}

__device__ __forceinline__ void rwkv_scan_row(Frame& F, int rid) {
    unsigned char* mx = F.ws + WS_MIX;
    const bf16* __restrict__ RR = (const bf16*)(mx + MX_RR); const bf16* __restrict__ RK = (const bf16*)(mx + MX_RK); const bf16* __restrict__ RV = (const bf16*)(mx + MX_RV);
    const bf16* __restrict__ RN = (const bf16*)(mx + MX_RN); const bf16* __restrict__ RA = (const bf16*)(mx + MX_RA); const float* __restrict__ RW = (const float*)(mx + MX_RWW);
    bf16* __restrict__ Y = (bf16*)(F.ws + WS_H);
    const int i = rid & 63, h = (rid >> 6) & 7, b = rid >> 9;
    const size_t base = (size_t)(b * T) * 512 + h * 64;
    float S = 0.f;
    for (int t = 0; t < T; t += 4) {
        float r[4], w[4], k[4], n[4], a[4], v[4];
#pragma unroll
        for (int u = 0; u < 4; ++u) { const size_t o = base + (size_t)(t + u) * 512 + F.lane;
            r[u] = bf2f(RR[o]); w[u] = RW[o]; k[u] = bf2f(RK[o]); n[u] = bf2f(RN[o]); a[u] = bf2f(RA[o]); v[u] = bf2f(RV[base + (size_t)(t + u) * 512 + i]); }
#pragma unroll
        for (int u = 0; u < 4; ++u) {
            const float sa = wave_sum(S * (-n[u]));
            S = S * w[u] + sa * (n[u] * a[u]) + v[u] * k[u];
            const float y = wave_sum(S * r[u]);
            if (F.lane == 0) Y[(size_t)(b * T + t + u) * D + YRW + h * 64 + i] = (bf16)f2bf(y);
        }
    }
}

__device__ __forceinline__ void ph_ml0(Frame& F, int l) {
    const bf16* Z = (const bf16*)(F.ws + WS_ZA);
    bf16* MQ = (bf16*)(F.ws + WS_MIX + MX_MQ); bf16* MK = (bf16*)(F.ws + WS_MIX + MX_MK);
    float* LF = (float*)(F.ws + WS_MLF); float* LI = (float*)(F.ws + WS_MLI);
    const float* cw = F.inp(15) + (size_t)l * 4 * 1024; const float* cb = F.inp(16) + (size_t)l * 1024; const float* gb = F.inp(17) + (size_t)l * 8;
    for (int m = F.bid; m < M; m += F.G) {
        const int t = m % T, b = m / T;
        for (int c = F.tid; c < 1024; c += NTHREADS) {
            float s = cb[c];
#pragma unroll
            for (int j = 0; j < 4; ++j) { const int tt = t - 3 + j; if (tt >= 0) s += cw[j * 1024 + c] * bf2f(Z[(size_t)(m - 3 + j) * NINP + ZMQ + c]); }
            s = siluf_(s);
            if (c < 512) MQ[(size_t)m * 512 + c] = (bf16)f2bf(s); else MK[(size_t)m * 512 + c - 512] = (bf16)f2bf(s * 0.08838834764831845f);
        }
        if (F.tid < 4) { const int h = F.tid; LI[(size_t)(b * 4 + h) * T + t] = bf2f(Z[(size_t)m * NINP + ZMI + h]) + gb[h];
            LF[(size_t)(b * 4 + h) * T + t] = logsigmoidf_(bf2f(Z[(size_t)m * NINP + ZMF + h]) + gb[4 + h]); }
    }
}
__device__ __forceinline__ void ph_ml1(Frame& F) {
    const bf16* Z = (const bf16*)(F.ws + WS_ZA);
    const bf16* MK = (const bf16*)(F.ws + WS_MIX + MX_MK);
    const float* LF = (const float*)(F.ws + WS_MLF); const float* LI = (const float*)(F.ws + WS_MLI);
    float* G_ = (float*)(F.ws + WS_MLG); float* A_ = G_ + 2048;
    float* U = (float*)(F.ws + WS_MIX + MX_U); float* NP = (float*)(F.ws + WS_MLNP);
    LAS float* kf = (LAS float*)F.lds; LAS float* vf = kf + 64 * 128; LAS float* wv = vf + 64 * 128; LAS float* bc = wv + 64;
    for (int it = F.bid; it < 2048; it += F.G) {
        const int bh = it >> 8, ck = it & 255, b = bh >> 2, h = bh & 3; const size_t m0 = (size_t)b * T + ck * 64;
        for (int i = F.tid; i < 64 * 128; i += NTHREADS) { const int s = i >> 7, d = i & 127; kf[i] = bf2f(MK[(m0 + s) * 512 + h * 128 + d]); vf[i] = bf2f(Z[(m0 + s) * NINP + ZMV + h * 128 + d]); }
        if (F.tid == 0) { float cum = 0.f; for (int s = 0; s < 64; ++s) { cum += LF[(size_t)bh * T + ck * 64 + s]; bc[s] = cum; }
            const float g = cum; float a = -INFINITY; for (int s = 0; s < 64; ++s) { const float lw = g - bc[s] + LI[(size_t)bh * T + ck * 64 + s]; wv[s] = lw; a = fmaxf(a, lw); }
            for (int s = 0; s < 64; ++s) wv[s] = __expf(wv[s] - a); G_[it] = g; A_[it] = a; }
        __syncthreads();
        { const int dk = F.tid & 127, dv0 = F.tid >> 7; float acc[32];
#pragma unroll
          for (int q = 0; q < 32; ++q) acc[q] = 0.f;
          float np = 0.f;
          for (int s = 0; s < 64; ++s) { const float kv = wv[s] * kf[s * 128 + dk]; np += kv;
#pragma unroll
              for (int q = 0; q < 32; ++q) acc[q] += vf[s * 128 + dv0 + 4 * q] * kv; }
#pragma unroll
          for (int q = 0; q < 32; ++q) U[(size_t)it * 16384 + (size_t)(dv0 + 4 * q) * 128 + dk] = acc[q];
          if (dv0 == 0) NP[(size_t)it * 128 + dk] = np; }
        __syncthreads();
    }
}
__device__ __forceinline__ void ph_ml2(Frame& F) {
    const float* G_ = (const float*)(F.ws + WS_MLG); const float* A_ = G_ + 2048; float* M_ = (float*)(F.ws + WS_MLG) + 4096;
    const float* U = (const float*)(F.ws + WS_MIX + MX_U); bf16* CT = (bf16*)(F.ws + WS_MIX + MX_CT);
    const float* NP = (const float*)(F.ws + WS_MLNP); float* NS = (float*)(F.ws + WS_MLNS);
    for (int gid = F.bid * NTHREADS + F.tid; gid < 8 * 16384; gid += F.G * NTHREADS) {
        const int bh = gid >> 14, e = gid & 16383;
        float C = 0.f, n = 0.f, m = 0.f;
        for (int k = 0; k < 256; ++k) { const int it = bh * 256 + k;
            CT[(size_t)it * 16384 + e] = (bf16)f2bf(C);
            if (e < 128) NS[(size_t)it * 128 + e] = n;
            if (e == 0) M_[it] = m;
            const float g = G_[it], a = A_[it]; const float mn = fmaxf(g + m, a); const float dec = __expf(g + m - mn), ee = __expf(a - mn);
            C = dec * C + ee * U[(size_t)it * 16384 + e];
            if (e < 128) n = dec * n + ee * NP[(size_t)it * 128 + e];
            m = mn; }
    }
}
__device__ __forceinline__ void ph_ml3(Frame& F, int l) {
    const bf16* Z = (const bf16*)(F.ws + WS_ZA);
    const bf16* MQ = (const bf16*)(F.ws + WS_MIX + MX_MQ); const bf16* MK = (const bf16*)(F.ws + WS_MIX + MX_MK);
    const float* LF = (const float*)(F.ws + WS_MLF); const float* LI = (const float*)(F.ws + WS_MLI);
    const float* M_ = (const float*)(F.ws + WS_MLG) + 4096; const bf16* CT = (const bf16*)(F.ws + WS_MIX + MX_CT); const float* NS = (const float*)(F.ws + WS_MLNS);
    const float* gn = F.inp(18) + (size_t)l * 512;
    bf16* Y = (bf16*)(F.ws + WS_H);
    LAS float* qf = (LAS float*)F.lds;
    LAS float* kf = qf + 64 * 128;
    LAS float* vf = kf + 64 * 129;
    LAS float* Sm = vf + 64 * 128;
    LAS float* Hb = Sm + 64 * 65;
    LAS float* bc = Hb + 64 * 128;
    LAS float* ig = bc + 64; LAS float* mt = ig + 64; LAS float* wi = mt + 64; LAS float* den = wi + 64;
    for (int it = F.bid; it < 2048; it += F.G) {
        const int bh = it >> 8, ck = it & 255, b = bh >> 2, h = bh & 3; const size_t m0 = (size_t)b * T + ck * 64;
        const float mprev = M_[it];
        for (int i = F.tid; i < 64 * 128; i += NTHREADS) { const int s = i >> 7, d = i & 127;
            qf[i] = bf2f(MQ[(m0 + s) * 512 + h * 128 + d]); kf[s * 129 + d] = bf2f(MK[(m0 + s) * 512 + h * 128 + d]); vf[i] = bf2f(Z[(m0 + s) * NINP + ZMV + h * 128 + d]); }
        if (F.tid == 0) { float cum = 0.f; for (int s = 0; s < 64; ++s) { cum += LF[(size_t)bh * T + ck * 64 + s]; bc[s] = cum; ig[s] = LI[(size_t)bh * T + ck * 64 + s]; } }
        __syncthreads();
        if (F.tid < 64) { const int t = F.tid; float mxv = bc[t] + mprev; for (int s = 0; s <= t; ++s) mxv = fmaxf(mxv, bc[t] - bc[s] + ig[s]); mt[t] = mxv; wi[t] = __expf(bc[t] + mprev - mxv); }
        __syncthreads();
        for (int r = 0; r < 8; ++r) { const int idx = F.tid + 512 * r, t = idx >> 6, s = idx & 63; float v = 0.f;
            if (s <= t) { float dsum = 0.f; for (int d = 0; d < 128; ++d) dsum += qf[t * 128 + d] * kf[s * 129 + d]; v = dsum * __expf(bc[t] - bc[s] + ig[s] - mt[t]); }
            Sm[t * 65 + s] = v; }
        __syncthreads();
        if (F.tid < 64) { const int t = F.tid; float s1 = 0.f; for (int s = 0; s < 64; ++s) s1 += Sm[t * 65 + s]; float qn = 0.f; for (int d = 0; d < 128; ++d) qn += qf[t * 128 + d] * NS[(size_t)it * 128 + d];
            den[t] = s1 + wi[t] * qn; }
        __syncthreads();
        for (int r = 0; r < 16; ++r) { const int idx = F.tid + 512 * r, t = idx >> 7, dv = idx & 127;
            float a1 = 0.f; for (int s = 0; s < 64; ++s) a1 += Sm[t * 65 + s] * vf[s * 128 + dv];
            float a2 = 0.f; const bf16* cr = CT + (size_t)it * 16384 + (size_t)dv * 128; for (int d = 0; d < 128; ++d) a2 += qf[t * 128 + d] * bf2f(cr[d]);
            const float num = a1 + wi[t] * a2; const float hh = num / fmaxf(fabsf(den[t]), __expf(-mt[t]));
            const float og = sigmoidf_(bf2f(Z[(m0 + t) * NINP + ZMO + h * 128 + dv]));
            Hb[t * 128 + dv] = og * hh; }
        __syncthreads();
        for (int r = 0; r < 8; ++r) { const int t = F.wave * 8 + r; const float x0 = Hb[t * 128 + F.lane], x1 = Hb[t * 128 + 64 + F.lane];
            const float mu = wave_sum(x0 + x1) * (1.0f / 128.0f); const float d0 = x0 - mu, d1 = x1 - mu; const float var = wave_sum(d0 * d0 + d1 * d1) * (1.0f / 128.0f); const float rs = 1.0f / sqrtf(var + 1e-6f);
            Y[(m0 + t) * D + YML + h * 128 + F.lane] = (bf16)f2bf(d0 * rs * gn[h * 128 + F.lane]); Y[(m0 + t) * D + YML + h * 128 + 64 + F.lane] = (bf16)f2bf(d1 * rs * gn[h * 128 + 64 + F.lane]); }
        __syncthreads();
    }
}

constexpr size_t WS_SW = 1174 * MiB;
constexpr size_t SW_WUP = 0, SW_AUP = 128 * 1024, SW_GUP = 256 * 1024, SW_W1T = 512 * 1024, SW_W2T = SW_W1T + 4 * 512 * 1024, SW_END = SW_W2T + 4 * 16 * 1024;
constexpr size_t WS_BON = 1178 * MiB;
constexpr size_t WS_PB = 1179 * MiB;
constexpr size_t WS_END3 = 1180 * MiB;
#ifndef SCAN_R_
#define SCAN_R_ 32
#endif
constexpr int SCAN_R = SCAN_R_;
typedef float v2f __attribute__((ext_vector_type(2)));
constexpr int SCAN_YSTAGE_OFF = 8192 + 3 * 17408;
constexpr int SCAN_RING_OFF = 8192 + 7 * 17408;
constexpr int ACT_LD = 136;

template <class TT> __device__ __forceinline__ TT ldg(const void* ubase, unsigned off) { return *(const GAS TT*)((const GAS char*)ubase + off); }
template <class TT> __device__ __forceinline__ void stg(void* ubase, unsigned off, TT v) { *(GAS TT*)((GAS char*)ubase + off) = v; }
__device__ __forceinline__ unsigned pkh2(float a, float b);
__device__ __forceinline__ float h2f_lo(unsigned w) { return (float)__builtin_bit_cast(_Float16, (unsigned short)(w & 0xffffu)); }
__device__ __forceinline__ float h2f_hi(unsigned w) { return (float)__builtin_bit_cast(_Float16, (unsigned short)(w >> 16)); }
__device__ __forceinline__ void ph_compress2(Frame& F, int l) {
    const bf16* Z = (const bf16*)(F.ws + WS_ZA);
    LAS unsigned short* hl = (LAS unsigned short*)F.lds;
    const int lane = F.lane, tk = lane & 15, g = lane >> 4, w = F.wave;
    for (int it = F.bid; it < 2 * NB * 4 * 64; it += F.G) {
        const int grp = it & 63, kvh = (it >> 6) & 3, b = (it >> 8) & 1, kv = it >> 9; const int lk = l * 2 + kv;
        const unsigned z0 = (unsigned)opq(0);
        const bf16* W1T = (const bf16*)(F.ws + WS_SW + SW_W1T) + (size_t)lk * 128 * 2048 + (size_t)w * 16 * 2048;
        const int i0 = grp * 16;
        const bf16* zc = Z + ((size_t)b * T + 16 * i0) * NINP + (kv ? ZVC : ZKC) + kvh * 64;
        const unsigned aoff = (unsigned)(tk * 2048 + 8 * g) * 2u + z0;
        const unsigned boff = (unsigned)(tk * 16 * NINP + 8 * g) * 2u + z0;
        const int tokbase = 16 * (i0 + tk);
        f32x4 acc = {0.f, 0.f, 0.f, 0.f};
        for (int k8 = 0; k8 < 64; k8 += 8) {
            bf16x8 af[8], bfv[8];
#pragma unroll
            for (int u = 0; u < 8; ++u) { const int ks = k8 + u; af[u] = ldg<bf16x8>(W1T, aoff + 64u * ks);
                const int tok = tokbase + (ks >> 1); v4u bw = {0u, 0u, 0u, 0u};
                if (tok < T) bw = ldg<v4u>(zc, boff + (unsigned)((ks >> 1) * NINP + 32 * (ks & 1)) * 2u);
                bfv[u] = __builtin_bit_cast(bf16x8, bw); }
#pragma unroll
            for (int u = 0; u < 8; ++u) acc = MFMA16(af[u], bfv[u], acc);
        }
        { const f32x4 pb = ldg<f32x4>(F.ws + WS_PB, (unsigned)(lk * 128 + w * 16 + 4 * g) * 4u + z0);
          v2u hv; hv.x = pk2(siluf_(acc[0] + pb[0]), siluf_(acc[1] + pb[1])); hv.y = pk2(siluf_(acc[2] + pb[2]), siluf_(acc[3] + pb[3]));
          *(LAS v2u*)(hl + tk * 136 + w * 16 + 4 * g) = hv; }
        __syncthreads();
        if (w < 4) {
            const bf16* W2T = (const bf16*)(F.ws + WS_SW + SW_W2T) + (size_t)lk * 64 * 128 + (size_t)w * 16 * 128;
            f32x4 o = {0.f, 0.f, 0.f, 0.f};
#pragma unroll
            for (int ks = 0; ks < 4; ++ks) { const bf16x8 a2 = ldg<bf16x8>(W2T, (unsigned)(tk * 128 + 8 * g + 32 * ks) * 2u + z0); const bf16x8 b2 = *(const LAS bf16x8*)(hl + tk * 136 + 32 * ks + 8 * g); o = MFMA16(a2, b2, o); }
            const int n = i0 + tk;
            if (kv == 0) { v2u ov; ov.x = pk2(o[0], o[1]); ov.y = pk2(o[2], o[3]);
                stg<v2u>(F.ws + WS_KC, (unsigned)(((b * 4 + kvh) * 1024 + n) * 64 + w * 16 + 4 * g) * 2u + z0, ov); }
            else {
#pragma unroll
                for (int r = 0; r < 4; ++r) stg<unsigned short>(F.ws + WS_VC, (unsigned)(((b * 4 + kvh) * 64 + w * 16 + 4 * g + r) * 1024 + n) * 2u + z0, (unsigned short)f2bf(o[r])); }
        }
        __syncthreads();
    }
}
template <int MODE> __device__ __forceinline__ void ph_rwkv2_tok(Frame& F, int l) {
    const bf16* Z = (const bf16*)(F.ws + WS_ZA);
    LAS unsigned short* act = (LAS unsigned short*)F.lds;
    const float* mu = F.inp(19) + (size_t)l * RWC;
    const int lane = F.lane, tk = lane & 15, g = lane >> 4, h = F.wave;
    const bf16* WUP = (const bf16*)(F.ws + WS_SW + SW_WUP) + (size_t)l * 512 * 64 + (size_t)h * 64 * 64;
    const bf16* AUP = (const bf16*)(F.ws + WS_SW + SW_AUP) + (size_t)l * 512 * 64 + (size_t)h * 64 * 64;
    const bf16* GUP = (const bf16*)(F.ws + WS_SW + SW_GUP) + (size_t)l * 512 * 128 + (size_t)h * 64 * 128;
    unsigned char* REC = F.ws + WS_MIX;
    float* BON = (float*)(F.ws + WS_BON);
    bf16* Y = (bf16*)(F.ws + WS_H);
    const unsigned choff_ = (unsigned)(h * 64 + 4 * g) * 4u;
    const float* pw0 = F.inp(20) + (size_t)l * 512; const float* pa0 = F.inp(22) + (size_t)l * 512; const float* pkk = F.inp(25) + (size_t)l * 512;
    const float* pka = F.inp(26) + (size_t)l * 512; const float* prk = F.inp(27) + (size_t)l * 512; const float* pln = F.inp(28) + (size_t)l * 1024;
    for (int tt = F.bid; tt < M / 64; tt += F.G) {
        const size_t m0 = (size_t)tt * 64; const int t0 = (int)(m0 % T);
        for (int i = F.tid; i < 64 * 32; i += NTHREADS) { const int tok = i >> 5, c4 = (i & 31) * 4; const int t = t0 + tok;
            const int col = (MODE == 0 ? 1536 : 1664) + c4;
            const bf16* zr = Z + m0 * NINP + ZRW; const unsigned zo = (unsigned)(tok * NINP + col) * 2u;
            const v2u zc = ldg<v2u>(zr, zo); v2u zp = {0u, 0u}; if (t > 0) zp = ldg<v2u>(zr - NINP, zo);
            const f32x4 mm = ldg<f32x4>(mu, (unsigned)col * 4u);
            float x[4] = {bflo(zc.x), bfhi(zc.x), bflo(zc.y), bfhi(zc.y)}; const float p[4] = {bflo(zp.x), bfhi(zp.x), bflo(zp.y), bfhi(zp.y)};
#pragma unroll
            for (int e = 0; e < 4; ++e) { x[e] = x[e] + mm[e] * (p[e] - x[e]); if (MODE == 0) { if (c4 < 64) x[e] = tanhf(x[e]); } else x[e] = sigmoidf_(x[e]); }
            LAS unsigned* d = (LAS unsigned*)(act + tok * ACT_LD + c4); d[0] = pk2(x[0], x[1]); d[1] = pk2(x[2], x[3]); }
        __syncthreads();
        for (int mt = 0; mt < 4; ++mt) {

            const unsigned z0 = (unsigned)opq(0);
            const unsigned choff = choff_ + z0;
            bf16x8 wa[4][4];
#pragma unroll
            for (int nt = 0; nt < 4; ++nt) {
                if (MODE == 0) { const unsigned o = (unsigned)((nt * 16 + tk) * 64 + 8 * g) * 2u + z0;
                    wa[nt][0] = ldg<bf16x8>(WUP, o); wa[nt][1] = ldg<bf16x8>(WUP, o + 64u); wa[nt][2] = ldg<bf16x8>(AUP, o); wa[nt][3] = ldg<bf16x8>(AUP, o + 64u); }
                else { const unsigned o = (unsigned)((nt * 16 + tk) * 128 + 8 * g) * 2u + z0;
#pragma unroll
                    for (int ks = 0; ks < 4; ++ks) wa[nt][ks] = ldg<bf16x8>(GUP, o + 64u * ks); } }
            const size_t mb = m0 + mt * 16; const int t = t0 + mt * 16 + tk;
            const bf16* zr = Z + mb * NINP + ZRW; const unsigned zo = (unsigned)(tk * NINP + h * 64 + 4 * g) * 2u + z0;
            bf16x8 bf[4];
#pragma unroll
            for (int ks = 0; ks < 4; ++ks) bf[ks] = *(const LAS bf16x8*)(act + (mt * 16 + tk) * ACT_LD + 32 * ks + 8 * g);
            if (MODE == 0) {
                float aq[4][4], nq[4][4], kqa[4][4]; float ssq = 0.f, bsum = 0.f;
#pragma unroll
                for (int nt = 0; nt < 4; ++nt) {
                    f32x4 cw = {0.f, 0.f, 0.f, 0.f}, ca = {0.f, 0.f, 0.f, 0.f};
                    cw = MFMA16(wa[nt][0], bf[0], cw); cw = MFMA16(wa[nt][1], bf[1], cw); ca = MFMA16(wa[nt][2], bf[2], ca); ca = MFMA16(wa[nt][3], bf[3], ca);
                    const unsigned co = choff + 64u * nt;
                    const f32x4 w0 = ldg<f32x4>(pw0, co), a0 = ldg<f32x4>(pa0, co), kkc = ldg<f32x4>(pkk, co), kac = ldg<f32x4>(pka, co), rkc = ldg<f32x4>(prk, co);
                    float zz[3][4];
#pragma unroll
                    for (int s = 0; s < 3; ++s) { const unsigned zc_o = zo + (unsigned)(512 * s + 16 * nt) * 2u; const v2u zc = ldg<v2u>(zr, zc_o); v2u zp = {0u, 0u}; if (t > 0) zp = ldg<v2u>(zr - NINP, zc_o);
                        const f32x4 mm = ldg<f32x4>(mu + 512 * s, co); const float x[4] = {bflo(zc.x), bfhi(zc.x), bflo(zc.y), bfhi(zc.y)}; const float p[4] = {bflo(zp.x), bfhi(zp.x), bflo(zp.y), bfhi(zp.y)};
#pragma unroll
                        for (int e = 0; e < 4; ++e) zz[s][e] = x[e] + mm[e] * (p[e] - x[e]); }
                    float dq[4], kq[4];
#pragma unroll
                    for (int e = 0; e < 4; ++e) { const float r = zz[0][e], k = zz[1][e];
                        const float ws_ = w0[e] + cw[e], a = sigmoidf_(a0[e] + ca[e]);
                        const float w_log = -softplusf_(-ws_) - 0.5f; dq[e] = __expf(-__expf(w_log));
                        const float kk = k * kkc[e]; ssq += kk * kk; nq[nt][e] = kk;
                        kq[e] = k * (1.0f + (a - 1.0f) * kac[e]); aq[nt][e] = a;
                        bsum += r * kq[e] * rkc[e]; }
                    const unsigned ro = (unsigned)(tk * 8 + h) * 1024u + z0;
                    stg<f32x4>(REC + mb * 8192, ro + (unsigned)(16 * nt + 4 * g) * 4u, (f32x4){dq[0], dq[1], dq[2], dq[3]});
                    stg<f32x4>(REC + mb * 8192, ro + 768u + (unsigned)(16 * nt + 4 * g) * 4u, (f32x4){zz[2][0], zz[2][1], zz[2][2], zz[2][3]});
                    v2u p0; p0.x = pkh2(zz[0][0], zz[0][1]); p0.y = pkh2(zz[0][2], zz[0][3]);
                    stg<v2u>(REC + mb * 8192, ro + 256u + (unsigned)(4 * nt + g) * 16u, p0);
#pragma unroll
                    for (int e = 0; e < 4; ++e) kqa[nt][e] = kq[e];

                }
                ssq = xsum4(ssq); bsum = xsum4(bsum);
                const float inr = 1.0f / fmaxf(sqrtf(ssq), 1e-12f);
                if (g == 0) stg<float>(BON + mb * 8 + h, (unsigned)tk * 32u, bsum);
#pragma unroll
                for (int nt = 0; nt < 4; ++nt) { float n4[4], b4[4];
#pragma unroll
                    for (int e = 0; e < 4; ++e) { n4[e] = nq[nt][e] * inr; b4[e] = n4[e] * aq[nt][e]; }
                    v2u p1; p1.x = pkh2(n4[0], n4[1]); p1.y = pkh2(n4[2], n4[3]);
                    stg<v2u>(REC + mb * 8192, (unsigned)(tk * 8 + h) * 1024u + z0 + 256u + (unsigned)(4 * nt + g) * 16u + 8u, p1);
                    v4u p2; p2.x = pkh2(kqa[nt][0], -b4[0]); p2.y = pkh2(kqa[nt][1], -b4[1]); p2.z = pkh2(kqa[nt][2], -b4[2]); p2.w = pkh2(kqa[nt][3], -b4[3]);
                    stg<v4u>(REC + mb * 8192, (unsigned)(tk * 8 + h) * 1024u + z0 + 512u + (unsigned)(4 * nt + g) * 16u, p2); }
            } else {
                float yq[4][4]; float ysum = 0.f;
                const unsigned yo = (unsigned)(tk * D + YRW + h * 64 + 4 * g) * 2u + z0;
#pragma unroll
                for (int nt = 0; nt < 4; ++nt) { const v2u yw = ldg<v2u>(Y + mb * D, yo + 32u * nt); yq[nt][0] = h2f_lo(yw.x); yq[nt][1] = h2f_hi(yw.x); yq[nt][2] = h2f_lo(yw.y); yq[nt][3] = h2f_hi(yw.y);
                    ysum += (yq[nt][0] + yq[nt][1]) + (yq[nt][2] + yq[nt][3]); }
                const float mean = xsum4(ysum) * (1.0f / 64.0f); float vs = 0.f;
#pragma unroll
                for (int nt = 0; nt < 4; ++nt)
#pragma unroll
                    for (int e = 0; e < 4; ++e) { const float d = yq[nt][e] - mean; vs += d * d; }
                const float rs = 1.0f / sqrtf(xsum4(vs) * (1.0f / 64.0f) + 64e-5f);
                const float bon = ldg<float>(BON + mb * 8 + h, (unsigned)tk * 32u);
#pragma unroll
                for (int nt = 0; nt < 4; ++nt) {
                    f32x4 cg = {0.f, 0.f, 0.f, 0.f};
#pragma unroll
                    for (int ks = 0; ks < 4; ++ks) cg = MFMA16(wa[nt][ks], bf[ks], cg);
                    const unsigned zc_o = zo + (unsigned)(1024 + 16 * nt) * 2u;
                    const v2u zc = ldg<v2u>(zr, zc_o); v2u zp = {0u, 0u}; if (t > 0) zp = ldg<v2u>(zr - NINP, zc_o);
                    const f32x4 mm = ldg<f32x4>(mu + 1024, choff + 64u * nt); const float x[4] = {bflo(zc.x), bfhi(zc.x), bflo(zc.y), bfhi(zc.y)}; const float p[4] = {bflo(zp.x), bfhi(zp.x), bflo(zp.y), bfhi(zp.y)};
                    const f32x4 l0 = ldg<f32x4>(pln, choff + 64u * nt), l1 = ldg<f32x4>(pln + 512, choff + 64u * nt);
                    float o[4];
#pragma unroll
                    for (int e = 0; e < 4; ++e) { const float v = x[e] + mm[e] * (p[e] - x[e]); o[e] = ((yq[nt][e] - mean) * rs * l0[e] + l1[e] + bon * v) * cg[e]; }
                    v2u w; w.x = pk2(o[0], o[1]); w.y = pk2(o[2], o[3]); stg<v2u>(Y + mb * D, yo + 32u * nt, w);
                     }
            }
        }
        __syncthreads();
    }
}

template <int CTRL> __device__ __forceinline__ float dpp_add(float v) { return v + dpp_mov<CTRL>(v); }
__device__ __forceinline__ float row16_sum(float v) { v = dpp_add<0xB1>(v); v = dpp_add<0x4E>(v); v = dpp_add<0x141>(v); return dpp_add<0x140>(v); }
typedef _Float16 h2v __attribute__((ext_vector_type(2)));
__device__ __forceinline__ float dot2z(unsigned a, h2v b) { float r; asm("v_dot2_f32_f16 %0, %1, %2, 0" : "=v"(r) : "v"(a), "v"(b)); return r; }
__device__ __forceinline__ float fmix_lo(unsigned h, float b, float c) { return __builtin_fmaf((float)__builtin_bit_cast(h2v, h).x, b, c); }
__device__ __forceinline__ float fmix_hi(unsigned h, float b, float c) { return __builtin_fmaf((float)__builtin_bit_cast(h2v, h).y, b, c); }
__device__ __forceinline__ unsigned pkh2(float a, float b) { const _Float16 ha = (_Float16)a, hb = (_Float16)b; return (unsigned)__builtin_bit_cast(unsigned short, ha) | ((unsigned)__builtin_bit_cast(unsigned short, hb) << 16); }
__device__ __forceinline__ float fmix2_lo(unsigned hk, unsigned hv, float c) { return __builtin_fmaf((float)__builtin_bit_cast(h2v, hk).x, (float)__builtin_bit_cast(h2v, hv).x, c); }
__device__ __forceinline__ float fmix2_hi(unsigned hk, unsigned hv, float c) { return __builtin_fmaf((float)__builtin_bit_cast(h2v, hk).y, (float)__builtin_bit_cast(h2v, hv).x, c); }
__device__ __forceinline__ void rwkv_scan_v2(Frame& F, int grp) {
    const int lane = lane_id_fresh(), c = lane & 15, rho = lane >> 4;
    const int bh = grp >> 4, b = bh >> 3, h = bh & 7, i = (grp & 15) * 4 + rho;
    const GAS unsigned char* recn = (const GAS unsigned char*)(F.ws + WS_MIX + ((size_t)(b * T) * 8 + h) * 1024) + lane * 16;
    GAS unsigned char* ys = (GAS unsigned char*)((bf16*)(F.ws + WS_H) + ((size_t)(b * T) + (lane & 31)) * D + YRW + h * 64 + (grp & 15) * 4 + 2 * (lane >> 5)) - (size_t)2 * D;
    LAS unsigned char* yst = F.lds + SCAN_YSTAGE_OFF;
    LAS unsigned char* ring = F.lds + SCAN_RING_OFF;
    constexpr int R = SCAN_R;
    static_assert(R <= 32 && T % R == 0, "ring depth");
#define SCAN_DMA(slot) do { __builtin_amdgcn_global_load_lds((const GAS unsigned*)recn, (LAS unsigned*)(ring + (slot) * 1024), 16, 0, 0); recn += 8192; asm volatile("" : "+v"(recn)); } while (0)
#pragma unroll
    for (int s = 0; s < R; ++s) SCAN_DMA(s);
    asm volatile("s_waitcnt vmcnt(0)" ::: "memory");
    const LAS unsigned char* aw = ring + 16 * c; const LAS unsigned char* ap = ring + 256 + 16 * c; const LAS unsigned char* av = ring + 768 + 4 * i;
    float S0 = 0.f, S1 = 0.f, S2 = 0.f, S3 = 0.f;
    f32x4 W[4]; v4u A[4], B[4]; unsigned V[4];
    const unsigned aw_ = (unsigned)(size_t)aw, apx_ = (unsigned)(size_t)ap, av_ = (unsigned)(size_t)av;
#define SCAN_LDS(buf, slot) do { \
        asm volatile("ds_read_b128 %0, %1 offset:%2" : "=v"(W[buf]) : "v"(aw_), "n"((slot) * 1024)); \
        asm volatile("ds_read_b128 %0, %1 offset:%2" : "=v"(A[buf]) : "v"(apx_), "n"((slot) * 1024)); \
        asm volatile("ds_read_b128 %0, %1 offset:%2" : "=v"(B[buf]) : "v"(apx_), "n"((slot) * 1024 + 256)); \
        asm volatile("ds_read_b32 %0, %1 offset:%2" : "=v"(V[buf]) : "v"(av_), "n"((slot) * 1024)); } while (0)
#define SCAN_SEE(buf, cnt) asm volatile("s_waitcnt lgkmcnt(%4)" : "+v"(W[buf]), "+v"(A[buf]), "+v"(B[buf]), "+v"(V[buf]) : "n"(cnt))
    W[2] = W[3] = (f32x4){0.f, 0.f, 0.f, 0.f}; A[2] = A[3] = B[2] = B[3] = (v4u){0u, 0u, 0u, 0u}; V[2] = V[3] = 0u;
    __builtin_amdgcn_s_setprio(3);
    for (int tb = 0; tb < T; tb += R) {
        SCAN_LDS(0, 0); SCAN_LDS(1, 1);
        SCAN_SEE(0, 0); SCAN_SEE(1, 0); SCAN_SEE(2, 0); SCAN_SEE(3, 0);
#pragma unroll
        for (int u = 0; u < R; ++u) {
            const int cu = u & 3, nu = (u + 2) & 3;
            if (u + 2 < R) { asm volatile("s_waitcnt vmcnt(%0)" :: "n"(R - 3) : "memory");
                SCAN_LDS(nu, u + 2); }
            if (u + 2 < R) SCAN_SEE(cu, 8); else if (u + 2 == R) SCAN_SEE(cu, 4); else SCAN_SEE(cu, 0);
            const f32x4 w = W[cu]; const v4u a = A[cu], kb = B[cu]; const float vf = __uint_as_float(V[cu]);
            const v4u ap_ = A[(u + 3) & 3];
            const h2v s01 = __builtin_bit_cast(h2v, __builtin_amdgcn_cvt_pkrtz(S0, S1)), s23 = __builtin_bit_cast(h2v, __builtin_amdgcn_cvt_pkrtz(S2, S3));
            const unsigned n01 = a.z, n23 = a.w, r01 = ap_.x, r23 = ap_.y;
            float p = __builtin_amdgcn_fdot2(__builtin_bit_cast(h2v, n23), s23, dot2z(n01, s01), false);
            float y = __builtin_amdgcn_fdot2(__builtin_bit_cast(h2v, r23), s23, dot2z(r01, s01), false);
            p = row16_sum(p);
            y = row16_sum(y);
            { const h2v vp = __builtin_bit_cast(h2v, __builtin_amdgcn_cvt_pkrtz(vf, p));
              const unsigned k0 = kb.x, k1 = kb.y, k2 = kb.z, k3 = kb.w;
              const v2f sw01 = (v2f){S0, S1} * (v2f){w.x, w.y}, sw23 = (v2f){S2, S3} * (v2f){w.z, w.w};
              S0 = __builtin_amdgcn_fdot2(__builtin_bit_cast(h2v, k0), vp, sw01.x, false); S1 = __builtin_amdgcn_fdot2(__builtin_bit_cast(h2v, k1), vp, sw01.y, false);
              S2 = __builtin_amdgcn_fdot2(__builtin_bit_cast(h2v, k2), vp, sw23.x, false); S3 = __builtin_amdgcn_fdot2(__builtin_bit_cast(h2v, k3), vp, sw23.y, false); }
            *(LAS float*)(yst + rho * 4 + u * 16) = y;
            if (u + 2 >= R) asm volatile("" ::: "memory");
            SCAN_DMA(u);
        }
        asm volatile("s_waitcnt vmcnt(%0)" :: "n"(R - 2) : "memory");
        { const v2f yy = *(const LAS v2f*)(yst + (lane & 31) * 16 + (lane >> 5) * 8); if (tb > 0 || (lane & 31) > 0) *(GAS unsigned*)ys = pkh2(yy.x, yy.y); ys += (size_t)R * 2 * D; asm volatile("" : "+v"(ys)); }
    }
    {
        const v4u al = A[3];
        const unsigned r01 = al.x, r23 = al.y;
        const h2v s01 = __builtin_bit_cast(h2v, __builtin_amdgcn_cvt_pkrtz(S0, S1)), s23 = __builtin_bit_cast(h2v, __builtin_amdgcn_cvt_pkrtz(S2, S3));
        float y = __builtin_amdgcn_fdot2(__builtin_bit_cast(h2v, r23), s23, __builtin_amdgcn_fdot2(__builtin_bit_cast(h2v, r01), s01, 0.f, false), false);
        y = row16_sum(y);
        *(GAS _Float16*)((bf16*)(F.ws + WS_H) + ((size_t)(b * T) + T - 1) * D + YRW + h * 64 + i) = (_Float16)y;
    }
#undef SCAN_LDS
#undef SCAN_SEE
    __builtin_amdgcn_s_setprio(0);
    asm volatile("s_waitcnt vmcnt(0)" ::: "memory");
#undef SCAN_DMA
}

constexpr int VT_LD = 72;
__device__ __forceinline__ void ph_mlA(Frame& F, int l) {
    const bf16* Z = (const bf16*)(F.ws + WS_ZA);
    bf16* MQ = (bf16*)(F.ws + WS_MIX + MX_MQ); bf16* MK = (bf16*)(F.ws + WS_MIX + MX_MK);
    float* LF = (float*)(F.ws + WS_MLF); float* LI = (float*)(F.ws + WS_MLI);
    float* G_ = (float*)(F.ws + WS_MLG); float* A_ = G_ + 2048;
    float* U = (float*)(F.ws + WS_MIX + MX_U); float* NP = (float*)(F.ws + WS_MLNP);
    LAS unsigned short* vT = (LAS unsigned short*)F.lds;
    LAS unsigned short* kT = vT + 128 * VT_LD;
    LAS float* wv = (LAS float*)(kT + 128 * VT_LD);
    LAS float* lfs = wv + 64;
    LAS float* cwl = lfs + 64;
    const float* cw = F.inp(15) + (size_t)l * 4 * 1024; const float* cb = F.inp(16) + (size_t)l * 1024; const float* gb = F.inp(17) + (size_t)l * 8;
    const int lane = F.lane, tk = lane & 15, g = lane >> 4;
    for (int it = F.bid; it < 2048; it += F.G) {
        const int bh = it >> 8, ck = it & 255, b = bh >> 2, h = bh & 3; const size_t m0 = (size_t)b * T + ck * 64; const int t0 = ck * 64;
        const unsigned z0 = (unsigned)opq(0);
        const bf16* zb = Z + m0 * NINP;
        if (F.wave == 0) {
            const float f = bf2f(ldg<unsigned short>(zb, (unsigned)(lane * NINP + ZMF + h) * 2u + z0)) + gb[4 + h];
            const float ii = bf2f(ldg<unsigned short>(zb, (unsigned)(lane * NINP + ZMI + h) * 2u + z0)) + gb[h];
            const float lf = logsigmoidf_(f);
            lfs[lane] = lf;
            const float cum = wave_prefix_sum(lf, lane);
            const float gtot = rdlane(cum, 63);
            const float lw = gtot - cum + ii; const float a = wave_max(lw);
            wv[lane] = __expf(lw - a);
            LF[(size_t)bh * T + t0 + lane] = lf; LI[(size_t)bh * T + t0 + lane] = ii;
            if (lane == 0) { G_[it] = gtot; A_[it] = a; }
        }
        for (int i = F.tid; i < 5 * 256; i += NTHREADS) { const int j = i >> 8, c = i & 255; const int ch = (c < 128) ? (h * 128 + c) : (512 + h * 128 + c - 128); cwl[i] = (j < 4) ? cw[j * 1024 + ch] : cb[ch]; }
        __syncthreads();
        for (int idx = F.tid; idx < 64 * 32; idx += NTHREADS) {
            const int s = idx >> 5, c8 = (idx & 31) * 8; const int zcol = (c8 < 128) ? (ZMQ + h * 128 + c8) : (ZMK + h * 128 + c8 - 128);
            float acc[8];
#pragma unroll
            for (int e = 0; e < 8; ++e) acc[e] = cwl[4 * 256 + c8 + e];
#pragma unroll
            for (int j = 0; j < 4; ++j) { const int tt = t0 + s - 3 + j;
                if (tt >= 0) { const v4u w = ldg<v4u>(zb - 3 * NINP, (unsigned)((s + j) * NINP + zcol) * 2u + z0); const float x[8] = {bflo(w.x), bfhi(w.x), bflo(w.y), bfhi(w.y), bflo(w.z), bfhi(w.z), bflo(w.w), bfhi(w.w)};
#pragma unroll
                    for (int e = 0; e < 8; ++e) acc[e] += cwl[j * 256 + c8 + e] * x[e]; } }
            unsigned short o[8];
            if (c8 < 128) {
#pragma unroll
                for (int e = 0; e < 8; ++e) o[e] = (unsigned short)f2bf(siluf_(acc[e]));
                v4u w; w.x = o[0] | ((unsigned)o[1] << 16); w.y = o[2] | ((unsigned)o[3] << 16); w.z = o[4] | ((unsigned)o[5] << 16); w.w = o[6] | ((unsigned)o[7] << 16);
                stg<v4u>(MQ + m0 * 512, (unsigned)(s * 512 + h * 128 + c8) * 2u + z0, w);
            } else {
                const float ws_ = wv[s];
#pragma unroll
                for (int e = 0; e < 8; ++e) { const float kv = siluf_(acc[e]) * 0.08838834764831845f; o[e] = (unsigned short)f2bf(kv); kT[(c8 - 128 + e) * VT_LD + s] = (unsigned short)f2bf(bf2f(o[e]) * ws_); }
                v4u w; w.x = o[0] | ((unsigned)o[1] << 16); w.y = o[2] | ((unsigned)o[3] << 16); w.z = o[4] | ((unsigned)o[5] << 16); w.w = o[6] | ((unsigned)o[7] << 16);
                stg<v4u>(MK + m0 * 512, (unsigned)(s * 512 + h * 128 + c8 - 128) * 2u + z0, w);
            }
        }
        for (int idx = F.tid; idx < 64 * 16; idx += NTHREADS) {
            const int s = idx >> 4, c8 = (idx & 15) * 8; const v4u w = ldg<v4u>(zb, (unsigned)(s * NINP + ZMV + h * 128 + c8) * 2u + z0);
            const unsigned short x[8] = {(unsigned short)w.x, (unsigned short)(w.x >> 16), (unsigned short)w.y, (unsigned short)(w.y >> 16), (unsigned short)w.z, (unsigned short)(w.z >> 16), (unsigned short)w.w, (unsigned short)(w.w >> 16)};
#pragma unroll
            for (int e = 0; e < 8; ++e) vT[(c8 + e) * VT_LD + s] = x[e]; }
        __syncthreads();
        {
            bf16x8 af[2];
#pragma unroll
            for (int ks = 0; ks < 2; ++ks) af[ks] = *(const LAS bf16x8*)(vT + (F.wave * 16 + tk) * VT_LD + 32 * ks + 8 * g);
            float* ub = U + (size_t)it * 16384;
#pragma unroll
            for (int j = 0; j < 8; ++j) { f32x4 acc = {0.f, 0.f, 0.f, 0.f};
#pragma unroll
                for (int ks = 0; ks < 2; ++ks) { const bf16x8 bfr = *(const LAS bf16x8*)(kT + (j * 16 + tk) * VT_LD + 32 * ks + 8 * g); acc = MFMA16(af[ks], bfr, acc); }
#pragma unroll
                for (int r = 0; r < 4; ++r) stg<float>(ub, (unsigned)((F.wave * 16 + 4 * g + r) * 128 + j * 16 + tk) * 4u + z0, acc[r]); }
            if (F.tid < 128) { float s = 0.f; for (int q = 0; q < 64; ++q) s += bf2f(kT[F.tid * VT_LD + q]); NP[(size_t)it * 128 + F.tid] = s; }
        }
        __syncthreads();
    }
}
__device__ __forceinline__ void ph_mlB(Frame& F) {
    const float* __restrict__ G_ = (const float*)(F.ws + WS_MLG); const float* __restrict__ A_ = G_ + 2048; float* __restrict__ M_ = (float*)(F.ws + WS_MLG) + 4096;
    const float* __restrict__ U = (const float*)(F.ws + WS_MIX + MX_U); bf16* __restrict__ CT = (bf16*)(F.ws + WS_MIX + MX_CT);
    const float* __restrict__ NP = (const float*)(F.ws + WS_MLNP); float* __restrict__ NS = (float*)(F.ws + WS_MLNS);
    for (int gid = F.bid * NTHREADS + F.tid; gid < 8 * 16384; gid += F.G * NTHREADS) {
        const int bh = gid >> 14, e = gid & 16383;
        float C = 0.f, n = 0.f, m = 0.f;
        for (int k0 = 0; k0 < 256; k0 += 8) {
            float u[8], np[8], gg[8], aa[8];
#pragma unroll
            for (int q = 0; q < 8; ++q) { const int it = bh * 256 + k0 + q; u[q] = U[(size_t)it * 16384 + e]; gg[q] = G_[it]; aa[q] = A_[it]; np[q] = (e < 128) ? NP[(size_t)it * 128 + e] : 0.f; }
#pragma unroll
            for (int q = 0; q < 8; ++q) { const int it = bh * 256 + k0 + q;
                CT[(size_t)it * 16384 + e] = (bf16)f2bf(C);
                if (e < 128) NS[(size_t)it * 128 + e] = n;
                if (e == 0) M_[it] = m;
                const float mn = fmaxf(gg[q] + m, aa[q]); const float dec = __expf(gg[q] + m - mn), ee = __expf(aa[q] - mn);
                C = dec * C + ee * u[q]; n = dec * n + ee * np[q]; m = mn; }
        }
    }
}
__device__ __forceinline__ void ph_mlC(Frame& F, int l) {
    const bf16* Z = (const bf16*)(F.ws + WS_ZA);
    const bf16* MQ = (const bf16*)(F.ws + WS_MIX + MX_MQ); const bf16* MK = (const bf16*)(F.ws + WS_MIX + MX_MK);
    const float* LF = (const float*)(F.ws + WS_MLF); const float* LI = (const float*)(F.ws + WS_MLI);
    const float* M_ = (const float*)(F.ws + WS_MLG) + 4096; const bf16* CT = (const bf16*)(F.ws + WS_MIX + MX_CT); const float* NS = (const float*)(F.ws + WS_MLNS);
    const float* gn = F.inp(18) + (size_t)l * 512;
    bf16* Y = (bf16*)(F.ws + WS_H);
    LAS unsigned short* vT = (LAS unsigned short*)F.lds;
    LAS float* bc = (LAS float*)(vT + 128 * VT_LD);
    LAS float* cs = bc + 64;
    LAS float* pm = cs + 64;
    LAS float* nv = pm + 64;
    LAS float* st = nv + 128;
    const int lane = F.lane, tk = lane & 15, g = lane >> 4, tt = F.wave & 3, dh = F.wave >> 2;
    for (int it = F.bid; it < 2048; it += F.G) {
        const int bh = it >> 8, ck = it & 255, b = bh >> 2, h = bh & 3; const size_t m0 = (size_t)b * T + ck * 64; const int t0 = ck * 64;
        const unsigned z0 = (unsigned)opq(0);
        const bf16* zb = Z + m0 * NINP;
        const float mprev = M_[it];
        if (F.wave == 0) {
            const float lf = LF[(size_t)bh * T + t0 + lane], ii = LI[(size_t)bh * T + t0 + lane];
            const float cum = wave_prefix_sum(lf, lane);
            const float c = ii - cum; cs[lane] = c;
            const float mx = wave_prefix_max(c, lane);
            pm[lane] = mx; bc[lane] = cum;
        } else if (F.wave == 1) { nv[lane] = NS[(size_t)it * 128 + lane]; nv[64 + lane] = NS[(size_t)it * 128 + 64 + lane]; }
        for (int idx = F.tid; idx < 64 * 16; idx += NTHREADS) {
            const int s = idx >> 4, c8 = (idx & 15) * 8; const v4u w = ldg<v4u>(zb, (unsigned)(s * NINP + ZMV + h * 128 + c8) * 2u + z0);
            const unsigned short x[8] = {(unsigned short)w.x, (unsigned short)(w.x >> 16), (unsigned short)w.y, (unsigned short)(w.y >> 16), (unsigned short)w.z, (unsigned short)(w.z >> 16), (unsigned short)w.w, (unsigned short)(w.w >> 16)};
#pragma unroll
            for (int e = 0; e < 8; ++e) vT[(c8 + e) * VT_LD + s] = x[e]; }
        __syncthreads();
        const int t = tt * 16 + tk;
        bf16x8 qf[4];
#pragma unroll
        for (int ks = 0; ks < 4; ++ks) qf[ks] = ldg<bf16x8>(MQ + m0 * 512, (unsigned)(t * 512 + h * 128 + 32 * ks + 8 * g) * 2u + z0);
        const float bt = bc[t], mt = bt + fmaxf(pm[t], mprev), wt = __expf(bt + mprev - mt);
        f32x4 P[4]; float dsum = 0.f;
#pragma unroll
        for (int sti = 0; sti < 4; ++sti) {
            P[sti] = (f32x4){0.f, 0.f, 0.f, 0.f};
            if (sti <= tt) {
                f32x4 S = {0.f, 0.f, 0.f, 0.f};
#pragma unroll
                for (int ks = 0; ks < 4; ++ks) { const bf16x8 kf = ldg<bf16x8>(MK + m0 * 512, (unsigned)((sti * 16 + tk) * 512 + h * 128 + 32 * ks + 8 * g) * 2u + z0); S = MFMA16(kf, qf[ks], S); }
                const f32x4 c4 = *(const LAS f32x4*)(cs + sti * 16 + 4 * g);
#pragma unroll
                for (int r = 0; r < 4; ++r) { const int s = sti * 16 + 4 * g + r; const float p = (s <= t) ? S[r] * __expf(bt + c4[r] - mt) : 0.f; P[sti][r] = p; dsum += p; }
            }
        }
        float qn = 0.f;
#pragma unroll
        for (int ks = 0; ks < 4; ++ks) { const v4u w = __builtin_bit_cast(v4u, qf[ks]); const f32x4 n0 = *(const LAS f32x4*)(nv + 32 * ks + 8 * g), n1 = *(const LAS f32x4*)(nv + 32 * ks + 8 * g + 4);
            qn += bflo(w.x) * n0[0] + bfhi(w.x) * n0[1] + bflo(w.y) * n0[2] + bfhi(w.y) * n0[3] + bflo(w.z) * n1[0] + bfhi(w.z) * n1[1] + bflo(w.w) * n1[2] + bfhi(w.w) * n1[3]; }
        const float den = xsum4(dsum) + wt * xsum4(qn);
        const float rden = 1.0f / fmaxf(fabsf(den), __expf(-mt));
        bf16x8 pf[2];
#pragma unroll
        for (int kk = 0; kk < 2; ++kk) { const v4u w = {cvtpk(P[2 * kk][0], P[2 * kk][1]), cvtpk(P[2 * kk][2], P[2 * kk][3]), cvtpk(P[2 * kk + 1][0], P[2 * kk + 1][1]), cvtpk(P[2 * kk + 1][2], P[2 * kk + 1][3])}; pf[kk] = __builtin_bit_cast(bf16x8, w); }
        float hv[4][4]; float s1 = 0.f, s2 = 0.f;
#pragma unroll
        for (int dvt = 0; dvt < 4; ++dvt) {
            const int dvr = dh * 64 + dvt * 16 + tk;
            f32x4 a1 = {0.f, 0.f, 0.f, 0.f}, a2 = {0.f, 0.f, 0.f, 0.f};
#pragma unroll
            for (int kk = 0; kk < 2; ++kk) { const v2u lo = *(const LAS v2u*)(vT + dvr * VT_LD + 32 * kk + 4 * g), hi = *(const LAS v2u*)(vT + dvr * VT_LD + 32 * kk + 16 + 4 * g);
                const v4u w = {lo.x, lo.y, hi.x, hi.y}; a1 = MFMA16(__builtin_bit_cast(bf16x8, w), pf[kk], a1); }
#pragma unroll
            for (int ks = 0; ks < 4; ++ks) { const bf16x8 cf = ldg<bf16x8>(CT + (size_t)it * 16384, (unsigned)(dvr * 128 + 32 * ks + 8 * g) * 2u + z0); a2 = MFMA16(cf, qf[ks], a2); }
            const v2u ow = ldg<v2u>(zb, (unsigned)(t * NINP + ZMO + h * 128 + dh * 64 + dvt * 16 + 4 * g) * 2u + z0);
            const float og[4] = {bflo(ow.x), bfhi(ow.x), bflo(ow.y), bfhi(ow.y)};
#pragma unroll
            for (int r = 0; r < 4; ++r) { const float x = sigmoidf_(og[r]) * ((a1[r] + wt * a2[r]) * rden); hv[dvt][r] = x; s1 += x; s2 += x * x; }
        }
        s1 = xsum4(s1); s2 = xsum4(s2);
        if (g == 0) { st[(dh * 64 + t) * 2] = s1; st[(dh * 64 + t) * 2 + 1] = s2; }
        __syncthreads();
        { const float o1 = st[((dh ^ 1) * 64 + t) * 2], o2 = st[((dh ^ 1) * 64 + t) * 2 + 1];
          const float mean = (s1 + o1) * (1.0f / 128.0f); const float var = fmaxf((s2 + o2) * (1.0f / 128.0f) - mean * mean, 0.f); const float rs = 1.0f / sqrtf(var + 1e-6f);
#pragma unroll
          for (int dvt = 0; dvt < 4; ++dvt) { const int dv = dh * 64 + dvt * 16 + 4 * g; const f32x4 gg = ldg<f32x4>(gn, (unsigned)(h * 128 + dv) * 4u + z0);
              float o[4];
#pragma unroll
              for (int r = 0; r < 4; ++r) o[r] = (hv[dvt][r] - mean) * rs * gg[r];
              v2u w; w.x = pk2(o[0], o[1]); w.y = pk2(o[2], o[3]); stg<v2u>(Y + m0 * D, (unsigned)(t * D + YML + h * 128 + dv) * 2u + z0, w); } }
        __syncthreads();
    }
}

constexpr float LOG2E = 1.4426950408889634f;
constexpr float QSCALE2 = 0.125f * 1.4426950408889634f;
constexpr size_t WS_VCT = 3 * MiB;
constexpr size_t WS_VTS = 1142 * MiB, WS_VTW = 1158 * MiB;
constexpr size_t WS_END2 = 1174 * MiB;
constexpr int CW_NSAQ = 8192;


typedef __amdgpu_buffer_rsrc_t brsrc;
__device__ __forceinline__ brsrc mk_rsrc(const void* p) { return __builtin_amdgcn_make_buffer_rsrc((void*)p, 0, 0x7fffffff, 0x00020000); }
struct LdOff { int q, g, kstride, vstride; };
__device__ __forceinline__ void nsa_ldk(bf16x8 (&k)[2][2], brsrc rs, int soff, const LdOff& lo) {
    const int o0 = opq(lo.q * lo.kstride + lo.g * 16); const int off[2] = {o0, o0 + 16 * lo.kstride};
#pragma unroll
    for (int t = 0; t < 2; ++t) { k[t][0] = __builtin_bit_cast(bf16x8, __builtin_amdgcn_raw_buffer_load_b128(rs, (int)off[t], soff, 0)); k[t][1] = __builtin_bit_cast(bf16x8, __builtin_amdgcn_raw_buffer_load_b128(rs, (int)off[t], soff + 64, 0)); }
}
__device__ __forceinline__ void nsa_ldv(bf16x8 (&v)[4], brsrc rs, int soff, const LdOff& lo) {
    const int o0 = opq(lo.q * lo.vstride + lo.g * 8); const int off[4] = {o0, o0 + 16 * lo.vstride, o0 + 32 * lo.vstride, o0 + 48 * lo.vstride};
#pragma unroll
    for (int dt = 0; dt < 4; ++dt) { const v2u lo = __builtin_bit_cast(v2u, __builtin_amdgcn_raw_buffer_load_b64(rs, (int)off[dt], soff, 0)), hi = __builtin_bit_cast(v2u, __builtin_amdgcn_raw_buffer_load_b64(rs, (int)off[dt], soff + 32, 0));
        const v4u w = {lo.x, lo.y, hi.x, hi.y}; v[dt] = __builtin_bit_cast(bf16x8, w); }
}
__device__ __forceinline__ void nsa_qk2(f32x4 (&S)[2][2], const bf16x8 (&kf)[2][2], const bf16x8 (&qf)[4][2], const int hp) {
#pragma unroll
    for (int t = 0; t < 2; ++t)
#pragma unroll
        for (int j = 0; j < 2; ++j) { f32x4 a = {0.f, 0.f, 0.f, 0.f}; a = MFMA16(kf[t][0], qf[2 * hp + j][0], a); S[t][j] = MFMA16(kf[t][1], qf[2 * hp + j][1], a); }
}
template <class EF> __device__ __forceinline__ void nsa_scores_near2(f32x4 (&S)[2][2], const EF& ef, const LAS f32x4* lut, float (&mx)[2], const int hp) {
    mx[0] = -INFINITY; mx[1] = -INFINITY;
#pragma unroll
    for (int t = 0; t < 2; ++t) { f32x4 bb[4]; bool ok[4];
#pragma unroll
        for (int r = 0; r < 4; ++r) { int li; ok[r] = ef(t, r, li); bb[r] = lut[li]; }
#pragma unroll
        for (int r = 0; r < 4; ++r)
#pragma unroll
            for (int j = 0; j < 2; ++j) { const float s = ok[r] ? fmaf(S[t][j][r], QSCALE2, bb[r][2 * hp + j]) : -INFINITY; S[t][j][r] = s; mx[j] = fmaxf(mx[j], s); } }
}
__device__ __forceinline__ float max8(const f32x4& a, const f32x4& b) { return fmaxf(fmaxf(fmaxf(a[0], a[1]), fmaxf(a[2], a[3])), fmaxf(fmaxf(b[0], b[1]), fmaxf(b[2], b[3]))); }
__device__ __forceinline__ void nsa_pv2(f32x4 (&O)[4][4], const f32x4 (&P)[2][2], const bf16x8 (&vf)[4], const int hp) {
#pragma unroll
    for (int j = 0; j < 2; ++j) { const v4u w = {cvtpk(P[0][j][0], P[0][j][1]), cvtpk(P[0][j][2], P[0][j][3]), cvtpk(P[1][j][0], P[1][j][1]), cvtpk(P[1][j][2], P[1][j][3])};
        const bf16x8 pf = __builtin_bit_cast(bf16x8, w);
#pragma unroll
        for (int dt = 0; dt < 4; ++dt) O[2 * hp + j][dt] = MFMA16(vf[dt], pf, O[2 * hp + j][dt]); }
}
template <bool FAR, class EF> __device__ __forceinline__ void nsa_step_online(bf16x8 (&kf)[2][2], bf16x8 (&vf)[4], const LAS bf16x8* qlds  , const EF& ef, const LAS f32x4* lut, bool on,
                                                                   float (&m)[4], float (&l)[4], f32x4 (&O)[4][4], brsrc krs, int ksoff, brsrc vrs, int vsoff, const LdOff& lo) {
#pragma unroll
    for (int hp = 0; hp < 2; ++hp) {
        f32x4 S[2][2]; float mx[2];
        bf16x8 qp[2][2];
#pragma unroll
        for (int j = 0; j < 2; ++j) { qp[j][0] = qlds[((2 * hp + j) * 2 + 0) * 64]; qp[j][1] = qlds[((2 * hp + j) * 2 + 1) * 64]; }
#pragma unroll
        for (int t = 0; t < 2; ++t)
#pragma unroll
            for (int j = 0; j < 2; ++j) { f32x4 a = {0.f, 0.f, 0.f, 0.f}; a = MFMA16(kf[t][0], qp[j][0], a); S[t][j] = MFMA16(kf[t][1], qp[j][1], a); }
        if (hp == 1) nsa_ldk(kf, krs, ksoff, lo);
        f32x4 bfar; if (FAR) bfar = lut[127];
        if (FAR) {
#pragma unroll
            for (int j = 0; j < 2; ++j) mx[j] = on ? fmaf(max8(S[0][j], S[1][j]), QSCALE2, bfar[2 * hp + j]) : -INFINITY;
        } else nsa_scores_near2(S, ef, lut, mx, hp);
        float alpha[2]; bool chg = false;
#pragma unroll
        for (int j = 0; j < 2; ++j) { const int h = 2 * hp + j; const float mall = xmax4(mx[j]); const float mn = fmaxf(m[h], mall); const float mref = (mn == -INFINITY) ? 0.f : mn;
            alpha[j] = __builtin_amdgcn_exp2f(m[h] - mref); chg = chg || (mn > m[h]); m[h] = mn;
            float ps = 0.f;
            if (FAR) { const float bm = on ? (bfar[h] - mref) : -INFINITY;
#pragma unroll
                for (int t = 0; t < 2; ++t)
#pragma unroll
                    for (int r = 0; r < 4; ++r) { const float p = __builtin_amdgcn_exp2f(fmaf(S[t][j][r], QSCALE2, bm)); S[t][j][r] = p; ps += p; }
            } else {
#pragma unroll
                for (int t = 0; t < 2; ++t)
#pragma unroll
                    for (int r = 0; r < 4; ++r) { const float p = __builtin_amdgcn_exp2f(S[t][j][r] - mref); S[t][j][r] = p; ps += p; } }
            l[h] = l[h] * alpha[j] + ps; }
        if (__builtin_amdgcn_ballot_w64(chg) != 0ull) {
#pragma unroll
            for (int j = 0; j < 2; ++j)
#pragma unroll
                for (int dt = 0; dt < 4; ++dt) O[2 * hp + j][dt] *= alpha[j]; }
        nsa_pv2(O, S, vf, hp);
        __builtin_amdgcn_sched_barrier(0);
    }
    nsa_ldv(vf, vrs, vsoff, lo);
}


#define MFMA8(a, b, c) __builtin_amdgcn_mfma_f32_16x16x32_fp8_fp8((a), (b), (c), 0, 0, 0)
__device__ __forceinline__ unsigned pk_fp8x4(float a, float b, float c, float d) { int w = __builtin_amdgcn_cvt_pk_fp8_f32(a, b, 0, false); w = __builtin_amdgcn_cvt_pk_fp8_f32(c, d, w, true); return (unsigned)w; }
__device__ __forceinline__ long mk64(unsigned a, unsigned b) { const v2u w = {a, b}; return __builtin_bit_cast(long, w); }
__device__ __forceinline__ void nsa_ldk8(v4u (&k)[2], brsrc rs, int soff, int ko) {
    const int o = opq(ko);
    k[0] = __builtin_bit_cast(v4u, __builtin_amdgcn_raw_buffer_load_b128(rs, o, soff, 0)); k[1] = __builtin_bit_cast(v4u, __builtin_amdgcn_raw_buffer_load_b128(rs, o, soff + 1024, 0));
}
__device__ __forceinline__ void nsa_ldv8(v2u (&v)[4], brsrc rs, int soff, int vo) {
    const int o = opq(vo);
#pragma unroll
    for (int dt = 0; dt < 4; ++dt) v[dt] = __builtin_bit_cast(v2u, __builtin_amdgcn_raw_buffer_load_b64(rs, o, soff + dt * 1024, 0));
}
template <bool FAR, class EF> __device__ __forceinline__ void nsa_step_online8(v4u (&kr)[2], v2u (&vr)[4], const LAS v4u* qlds  , const EF& ef, const LAS f32x4* lut, bool on,
                                                                   float (&m)[4], float (&l)[4], f32x4 (&O)[4][4], brsrc krs, int ksoff, brsrc vrs, int vsoff, int ko, int vo) {
#pragma unroll
    for (int hp = 0; hp < 2; ++hp) {
        f32x4 S[2][2]; float mx[2];
        v4u qp[2];
#pragma unroll
        for (int j = 0; j < 2; ++j) qp[j] = qlds[(2 * hp + j) * 64];
#pragma unroll
        for (int t = 0; t < 2; ++t)
#pragma unroll
            for (int j = 0; j < 2; ++j) { f32x4 a = {0.f, 0.f, 0.f, 0.f}; a = MFMA8(mk64(kr[t].x, kr[t].y), mk64(qp[j].x, qp[j].y), a); S[t][j] = MFMA8(mk64(kr[t].z, kr[t].w), mk64(qp[j].z, qp[j].w), a); }
        if (hp == 1) nsa_ldk8(kr, krs, ksoff, ko);
        f32x4 bfar; if (FAR) bfar = lut[127];
        if (FAR) {
#pragma unroll
            for (int j = 0; j < 2; ++j) mx[j] = on ? fmaf(max8(S[0][j], S[1][j]), QSCALE2, bfar[2 * hp + j]) : -INFINITY;
        } else nsa_scores_near2(S, ef, lut, mx, hp);
        float alpha[2]; bool chg = false;
#pragma unroll
        for (int j = 0; j < 2; ++j) { const int h = 2 * hp + j; const float mall = xmax4(mx[j]); const float mn = fmaxf(m[h], mall); const float mref = (mn == -INFINITY) ? 0.f : mn;
            alpha[j] = __builtin_amdgcn_exp2f(m[h] - mref); chg = chg || (mn > m[h]); m[h] = mn;
            float ps = 0.f;
            if (FAR) { const float bm = on ? (bfar[h] - mref) : -INFINITY;
#pragma unroll
                for (int t = 0; t < 2; ++t)
#pragma unroll
                    for (int r = 0; r < 4; ++r) { const float p = __builtin_amdgcn_exp2f(fmaf(S[t][j][r], QSCALE2, bm)); S[t][j][r] = p; ps += p; }
            } else {
#pragma unroll
                for (int t = 0; t < 2; ++t)
#pragma unroll
                    for (int r = 0; r < 4; ++r) { const float p = __builtin_amdgcn_exp2f(S[t][j][r] - mref); S[t][j][r] = p; ps += p; } }
            l[h] = l[h] * alpha[j] + ps; }
        if (__builtin_amdgcn_ballot_w64(chg) != 0ull) {
#pragma unroll
            for (int j = 0; j < 2; ++j)
#pragma unroll
                for (int dt = 0; dt < 4; ++dt) O[2 * hp + j][dt] *= alpha[j]; }
#pragma unroll
        for (int j = 0; j < 2; ++j) { const long pf = mk64(pk_fp8x4(S[0][j][0], S[0][j][1], S[0][j][2], S[0][j][3]), pk_fp8x4(S[1][j][0], S[1][j][1], S[1][j][2], S[1][j][3]));
#pragma unroll
            for (int dt = 0; dt < 4; ++dt) O[2 * hp + j][dt] = MFMA8(mk64(vr[dt].x, vr[dt].y), pf, O[2 * hp + j][dt]); }
        __builtin_amdgcn_sched_barrier(0);
    }
    nsa_ldv8(vr, vrs, vsoff, vo);
}


__device__ __forceinline__ float max3f(float a, float b, float c) { float r; asm("v_max3_f32 %0, %1, %2, %3" : "=v"(r) : "v"(a), "v"(b), "v"(c)); return r; }
__device__ __forceinline__ float max2f(float a, float b) { float r; asm("v_max_f32 %0, %1, %2" : "=v"(r) : "v"(a), "v"(b)); return r; }
__device__ __forceinline__ float xmax4a(float x) { const auto s = __builtin_amdgcn_permlane16_swap(__float_as_uint(x), __float_as_uint(x), false, false); x = max2f(__uint_as_float(s[0]), __uint_as_float(s[1]));
    const auto t = __builtin_amdgcn_permlane32_swap(__float_as_uint(x), __float_as_uint(x), false, false); return max2f(__uint_as_float(t[0]), __uint_as_float(t[1])); }
__device__ __forceinline__ void slc_block4(const bool far, v4u (&kr)[4], v4u (&vr)[4], const v4u& qf, const int e0, const bool on, const LAS float* lutf  ,
                                           float& m, float& l, f32x4 (&O)[4], brsrc krs, brsrc vrs, int soffn, int ko, int vo) {
    f32x4 S[4];
#pragma unroll
    for (int t = 0; t < 4; ++t) { f32x4 a = {0.f, 0.f, 0.f, 0.f}; a = MFMA8(mk64(kr[t].x, kr[t].y), mk64(qf.x, qf.y), a); S[t] = MFMA8(mk64(kr[t].z, kr[t].w), mk64(qf.z, qf.w), a); }
    { const int o = opq(ko);
#pragma unroll
      for (int t = 0; t < 4; ++t) kr[t] = __builtin_bit_cast(v4u, __builtin_amdgcn_raw_buffer_load_b128(krs, o, soffn + t * 1024, 0)); }
    float alpha, ps = 0.f; bool chg;
    if (far) { const float bfar = lutf[127 * 4];
        float mx = max3f(S[0][0], S[0][1], S[0][2]); mx = max3f(mx, S[0][3], S[1][0]); mx = max3f(mx, S[1][1], S[1][2]); mx = max3f(mx, S[1][3], S[2][0]);
        mx = max3f(mx, S[2][1], S[2][2]); mx = max3f(mx, S[2][3], S[3][0]); mx = max3f(mx, S[3][1], S[3][2]); mx = max2f(mx, S[3][3]);
        const float mxs = on ? fmaf(mx, QSCALE2, bfar) : -INFINITY;
        const float mall = xmax4a(mxs); const float mn = max2f(m, mall); const float mref = (mn == -INFINITY) ? 0.f : mn;
        alpha = __builtin_amdgcn_exp2f(m - mref); chg = mn > m; m = mn;
        const float bm = on ? (bfar - mref) : -INFINITY;
#pragma unroll
        for (int t = 0; t < 4; ++t)
#pragma unroll
            for (int r = 0; r < 4; ++r) { const float p = __builtin_amdgcn_exp2f(fmaf(S[t][r], QSCALE2, bm)); S[t][r] = p; ps += p; }
    } else { float mx = -INFINITY;
#pragma unroll
        for (int t = 0; t < 4; ++t)
#pragma unroll
            for (int r = 0; r < 4; ++r) { const int d = e0 - (16 * t + r); const int li = d < 0 ? 0 : (d > 127 ? 127 : d); const bool ok = on && d >= 0;
                const float bb = lutf[li * 4]; const float s = ok ? fmaf(S[t][r], QSCALE2, bb) : -INFINITY; S[t][r] = s; mx = fmaxf(mx, s); }
        const float mall = xmax4(mx); const float mn = fmaxf(m, mall); const float mref = (mn == -INFINITY) ? 0.f : mn;
        alpha = __builtin_amdgcn_exp2f(m - mref); chg = mn > m; m = mn;
#pragma unroll
        for (int t = 0; t < 4; ++t)
#pragma unroll
            for (int r = 0; r < 4; ++r) { const float p = __builtin_amdgcn_exp2f(S[t][r] - mref); S[t][r] = p; ps += p; } }
    l = l * alpha + ps;
    if (__builtin_amdgcn_ballot_w64(chg) != 0ull) {
#pragma unroll
        for (int dt = 0; dt < 4; ++dt) O[dt] *= alpha; }
    const long pf0 = mk64(pk_fp8x4(S[0][0], S[0][1], S[0][2], S[0][3]), pk_fp8x4(S[1][0], S[1][1], S[1][2], S[1][3]));
    const long pf1 = mk64(pk_fp8x4(S[2][0], S[2][1], S[2][2], S[2][3]), pk_fp8x4(S[3][0], S[3][1], S[3][2], S[3][3]));
#pragma unroll
    for (int dt = 0; dt < 4; ++dt) { O[dt] = MFMA8(mk64(vr[dt].x, vr[dt].y), pf0, O[dt]); O[dt] = MFMA8(mk64(vr[dt].z, vr[dt].w), pf1, O[dt]); }
    { const int o = opq(vo);
#pragma unroll
      for (int dt = 0; dt < 4; ++dt) vr[dt] = __builtin_bit_cast(v4u, __builtin_amdgcn_raw_buffer_load_b128(vrs, o, soffn + dt * 1024, 0)); }
}

struct EfCmp { int n0, nvq, tq; __device__ __forceinline__ EfCmp(int nbase, int g, int nvq_, int tq_) : n0(opq(nbase + 4 * g)), nvq(nvq_), tq(tq_) {}
    __device__ __forceinline__ bool operator()(int t, int r, int& li) const { const int n = n0 + (16 * t + r); const int d = tq - 16 * n - 31; li = d < 0 ? 0 : (d > 127 ? 127 : d); return n < nvq; } };
struct EfWin { int e0; __device__ __forceinline__ EfWin(int nbase, int g, int tq) : e0(opq(tq - nbase - 4 * g)) {}
    __device__ __forceinline__ bool operator()(int t, int r, int& li) const { const int d = e0 - (16 * t + r); li = d < 0 ? 0 : (d > 127 ? 127 : d); return d >= 0 && d < 512; } };
struct EfSlc { int e0; bool sel; __device__ __forceinline__ EfSlc(int nbase, int g, int tq, bool sel_) : e0(opq(tq - nbase - 4 * g)), sel(sel_) {}
    __device__ __forceinline__ bool operator()(int t, int r, int& li) const { const int d = e0 - (16 * t + r); li = d < 0 ? 0 : (d > 127 ? 127 : d); return sel && d >= 0; } };

__device__ __forceinline__ void nsa2_task(Frame& F, int task, LAS float* tab, LAS unsigned* selm, LAS unsigned short* blist, const LAS f32x4* lut16) {
    int lane = lane_id_fresh(), q = lane & 15, g = lane >> 4;
    const int qg = 1023 - (task >> 3), bk = task & 7, b = bk >> 2, kvh = bk & 3;
    const int t0 = qg * 16; int tq = t0 + q;
#define NSA_FRESH() do { lane = opq(lane); q = lane & 15; g = lane >> 4; tq = t0 + q; } while (0)
    const size_t m0 = (size_t)b * T + t0;
    const bf16* Z = (const bf16*)(F.ws + WS_ZA);
    const bf16* zb = Z + (size_t)b * T * NINP;
    const LAS f32x4* lut = lut16 + kvh * 128;
    bf16x8 qf[4][2];
#pragma unroll
    for (int h = 0; h < 4; ++h) { const bf16* p = Z + (m0 + q) * NINP + ZQ + (kvh * 4 + h) * 64 + 8 * g; qf[h][0] = *(const bf16x8*)p; qf[h][1] = *(const bf16x8*)(p + 32); }
    f32x4 O[4][4];
#pragma unroll
    for (int h = 0; h < 4; ++h)
#pragma unroll
        for (int dt = 0; dt < 4; ++dt) O[h][dt] = (f32x4){0.f, 0.f, 0.f, 0.f};
#pragma unroll
    for (int i = 0; i < 64; ++i) tab[i * 64 + lane] = 0.f;
    {
        const int nvq = (tq >= 31) ? ((tq - 31) >> 4) + 1 : 0;
        const int nvmax = (t0 >= 16) ? (t0 >> 4) : 0;
        const int nsteps = (nvmax + 31) >> 5;
        if (nsteps > 0) {
            const bf16* KC = (const bf16*)(F.ws + WS_KC) + (size_t)(b * 4 + kvh) * 1024 * 64;
            const bf16* VCT = (const bf16*)(F.ws + WS_VCT) + (size_t)(b * 4 + kvh) * 64 * 1024;
            float mp[4] = {-INFINITY, -INFINITY, -INFINITY, -INFINITY}, lp[4] = {0.f, 0.f, 0.f, 0.f};
            bf16x8 kf[2][2];
            const brsrc krs = mk_rsrc(KC), vrs = mk_rsrc(VCT); const LdOff lo{q, g, 128, 2048};
            nsa_ldk(kf, krs, 0, lo);
            for (int s = 0; s < nsteps; ++s) {
                const int sn = (s + 1 < nsteps) ? s + 1 : s;
                const bool far = (s * 32 + 31 < nvmax - 1) && (t0 - 16 * (s * 32 + 31) - 31 >= 127);
#pragma unroll
                for (int hp = 0; hp < 2; ++hp) {
                    f32x4 S[2][2]; float mx[2];
                    nsa_qk2(S, kf, qf, hp);
                    if (hp == 1) nsa_ldk(kf, krs, sn * 32 * 64 * 2, lo);
                    if (far) { const f32x4 bfar = lut[127];
#pragma unroll
                        for (int j = 0; j < 2; ++j) { const int h = 2 * hp + j; const float mxh = fmaf(max8(S[0][j], S[1][j]), QSCALE2, bfar[h]); const float mn = fmaxf(mp[h], mxh); const float bm = bfar[h] - mn; float ps = 0.f;
#pragma unroll
                            for (int t = 0; t < 2; ++t)
#pragma unroll
                                for (int r = 0; r < 4; ++r) ps += __builtin_amdgcn_exp2f(fmaf(S[t][j][r], QSCALE2, bm));
                            lp[h] = lp[h] * __builtin_amdgcn_exp2f(mp[h] - mn) + ps; mp[h] = mn; }
                    } else {
                        EfCmp ef(s * 32, g, nvq, tq);
                        nsa_scores_near2(S, ef, lut, mx, hp);
#pragma unroll
                        for (int j = 0; j < 2; ++j) { const int h = 2 * hp + j; const float mn = fmaxf(mp[h], mx[j]); const float mref = (mn == -INFINITY) ? 0.f : mn; float ps = 0.f;
#pragma unroll
                            for (int t = 0; t < 2; ++t)
#pragma unroll
                                for (int r = 0; r < 4; ++r) ps += __builtin_amdgcn_exp2f(S[t][j][r] - mref);
                            lp[h] = lp[h] * __builtin_amdgcn_exp2f(mp[h] - mref) + ps; mp[h] = mn; }
                    }
                    __builtin_amdgcn_sched_barrier(0);
                }
            }
            float mall[4], pscale[4], oscale[4];
#pragma unroll
            for (int h = 0; h < 4; ++h) { const float ma = xmax4(mp[h]); const float mref = (ma == -INFINITY) ? 0.f : ma; const float lt = xsum4(lp[h] * __builtin_amdgcn_exp2f(mp[h] - mref));
                mall[h] = mref; pscale[h] = lt > 0.f ? 1.0f / lt : 0.f;
                oscale[h] = pscale[h] * sigmoidf_(bf2f(Z[(m0 + q) * NINP + ZGT + (kvh * 4 + h) * 3 + 0])); }
            float prev3 = 0.f;
            bf16x8 vf[4];
            nsa_ldk(kf, krs, 0, lo); nsa_ldv(vf, vrs, 0, lo);
            for (int s = 0; s < nsteps; ++s) {
                const int sn = (s + 1 < nsteps) ? s + 1 : s;
                const bool far = (s * 32 + 31 < nvmax - 1) && (t0 - 16 * (s * 32 + 31) - 31 >= 127);
                float psum[2][4];
#pragma unroll
                for (int t = 0; t < 2; ++t)
#pragma unroll
                    for (int r = 0; r < 4; ++r) psum[t][r] = 0.f;
#pragma unroll
                for (int hp = 0; hp < 2; ++hp) {
                    f32x4 S[2][2]; float mx[2];
                    nsa_qk2(S, kf, qf, hp);
                    if (hp == 1) nsa_ldk(kf, krs, sn * 32 * 64 * 2, lo);
                    if (far) { const f32x4 bfar = lut[127];
#pragma unroll
                        for (int t = 0; t < 2; ++t)
#pragma unroll
                            for (int j = 0; j < 2; ++j)
#pragma unroll
                                for (int r = 0; r < 4; ++r) S[t][j][r] = fmaf(S[t][j][r], QSCALE2, bfar[2 * hp + j]);
                    } else { EfCmp ef(s * 32, g, nvq, tq); nsa_scores_near2(S, ef, lut, mx, hp); }
#pragma unroll
                    for (int j = 0; j < 2; ++j)
#pragma unroll
                        for (int t = 0; t < 2; ++t)
#pragma unroll
                            for (int r = 0; r < 4; ++r) { const int h = 2 * hp + j; const float p = __builtin_amdgcn_exp2f(S[t][j][r] - mall[h]); psum[t][r] += p * pscale[h]; S[t][j][r] = p * oscale[h]; }
                    nsa_pv2(O, S, vf, hp);
                    __builtin_amdgcn_sched_barrier(0);
                }
                nsa_ldv(vf, vrs, sn * 32 * 2, lo);
#pragma unroll
                for (int t = 0; t < 2; ++t) { const float x3 = psum[t][3], x4 = (psum[t][0] + psum[t][1]) + (psum[t][2] + x3);
                    const float up = bperm(x3, (lane + 48) & 63);
                    const float wr = bperm(prev3, (lane + 48) & 63);
                    tab[(s * 2 + t) * 64 + lane] = x4 + (g == 0 ? wr : up);
                    prev3 = x3; }
            }
        }
    }
    NSA_FRESH();
    LDS_WAIT(); asm volatile("" ::: "memory");
    {
        float v[64];
        const int cur = t0 >> 6;
        const int c0 = cur - g, c1 = cur - 1 - g, tlim = (tq >> 6) - g;
#pragma unroll
        for (int i = 0; i < 64; ++i) { const float sc = tab[i * 64 + lane]; const bool forced = (4 * i == -g) || (4 * i == c0) || (4 * i == c1); const bool ok = 4 * i <= tlim;
            v[i] = forced ? 1e30f : (ok ? sc : -1e30f); }
        LDS_WAIT(); asm volatile("" ::: "memory");
        { LAS unsigned* tp = (LAS unsigned*)tab;
#pragma unroll
          for (int h = 0; h < 4; ++h)
#pragma unroll
              for (int dt = 0; dt < 4; ++dt) { tp[((h * 4 + dt) * 2 + 0) * 64 + lane] = cvtpk(O[h][dt][0], O[h][dt][1]); tp[((h * 4 + dt) * 2 + 1) * 64 + lane] = cvtpk(O[h][dt][2], O[h][dt][3]); }
          LAS v4u* qd = (LAS v4u*)(tab + 2048) + lane;
#pragma unroll
          for (int h = 0; h < 4; ++h) { const v4u a = __builtin_bit_cast(v4u, qf[h][0]), c = __builtin_bit_cast(v4u, qf[h][1]);
              const v4u w = {pk_fp8x4(bflo(a.x), bfhi(a.x), bflo(a.y), bfhi(a.y)), pk_fp8x4(bflo(a.z), bfhi(a.z), bflo(a.w), bfhi(a.w)), pk_fp8x4(bflo(c.x), bfhi(c.x), bflo(c.y), bfhi(c.y)), pk_fp8x4(bflo(c.z), bfhi(c.z), bflo(c.w), bfhi(c.w))};
              qd[h * 64] = w; } }
        unsigned w0 = 0u, w1 = 0u;
        for (int rnd = 0; rnd < 16; ++rnd) {
            float bv = -INFINITY; int bi = 1 << 18;
#pragma unroll
            for (int i = 0; i < 64; ++i) { if (v[i] > bv) { bv = v[i]; bi = i; } }
            int bj = 4 * bi + g;
            { const float ov = swz16(bv); const int oj = swz16i(bj); if (ov > bv || (ov == bv && oj < bj)) { bv = ov; bj = oj; }
              const auto rv = __builtin_amdgcn_permlane32_swap(__float_as_uint(bv), __float_as_uint(bv), false, false); const auto rj = __builtin_amdgcn_permlane32_swap((unsigned)bj, (unsigned)bj, false, false);
              const float v0 = __uint_as_float(rv[0]), v1 = __uint_as_float(rv[1]); const int j0 = (int)rj[0], j1 = (int)rj[1];
              if (v1 > v0 || (v1 == v0 && j1 < j0)) { bv = v1; bj = j1; } else { bv = v0; bj = j0; } }
            { const bool mine = (bj & 3) == g; const int wi = mine ? (bj >> 2) : -1;
#pragma unroll
              for (int i = 0; i < 64; ++i) { if (wi == i) v[i] = -INFINITY; } }
            if (bv > -1e29f && (bj >> 6) == g) { if (bj & 32) w1 |= 1u << (bj & 31); else w0 |= 1u << (bj & 31); }
        }
        selm[q * 8 + 2 * g] = w0; selm[q * 8 + 2 * g + 1] = w1;
    }
    LDS_WAIT(); asm volatile("" ::: "memory");
    NSA_FRESH();
    {
        int nbl[4];
#pragma unroll
        for (int gp = 0; gp < 4; ++gp) {
            unsigned uw = 0u;
            if (lane < 8) {
#pragma unroll
                for (int qq = 0; qq < 4; ++qq) uw |= selm[(4 * gp + qq) * 8 + lane]; }
            int n = 0;
            for (int w = 0; w < 8; ++w) { unsigned bits = (unsigned)__builtin_amdgcn_readlane((int)uw, w);
                while (bits) { const int j = w * 32 + __builtin_ctz(bits); bits &= bits - 1; if (lane == 0) blist[gp * 64 + n] = (unsigned short)j; ++n; } }
            nbl[gp] = n;
        }
        LDS_WAIT(); asm volatile("" ::: "memory");
        const unsigned char* KS = F.ws + WS_VTS + (size_t)(b * 4 + kvh) * T * 64;
        const unsigned char* VTS = F.ws + WS_VTS + 8 * MiB + (size_t)(b * 4 + kvh) * T * 64;
        const brsrc krs = mk_rsrc(KS), vrs = mk_rsrc(VTS);
#pragma unroll
        for (int pp = 0; pp < 2; ++pp) {
            NSA_FRESH();
            const int qi = q >> 2, hh = q & 3; const int ko = q * 64 + g * 16, vo = q * 64 + g * 16;
            const LAS float* lutf = (const LAS float*)lut + hh;
            f32x4 Og[2][4]; float mg[2] = {-INFINITY, -INFINITY}, lg[2] = {0.f, 0.f};
            v4u kf[2][4], vf[2][4], qf8[2]; int jc[2];
#pragma unroll
            for (int u = 0; u < 2; ++u) { const int gp = 2 * pp + u;
#pragma unroll
                for (int dt = 0; dt < 4; ++dt) Og[u][dt] = (f32x4){0.f, 0.f, 0.f, 0.f};
                const bf16* p = Z + (m0 + 4 * gp + qi) * NINP + ZQ + (kvh * 4 + hh) * 64 + 8 * g; const v4u a = *(const v4u*)p, c = *(const v4u*)(p + 32);
                qf8[u] = (v4u){pk_fp8x4(bflo(a.x), bfhi(a.x), bflo(a.y), bfhi(a.y)), pk_fp8x4(bflo(a.z), bfhi(a.z), bflo(a.w), bfhi(a.w)), pk_fp8x4(bflo(c.x), bfhi(c.x), bflo(c.y), bfhi(c.y)), pk_fp8x4(bflo(c.z), bfhi(c.z), bflo(c.w), bfhi(c.w))};
                jc[u] = __builtin_amdgcn_readfirstlane((int)blist[gp * 64]);
#pragma unroll
                for (int t = 0; t < 4; ++t) { kf[u][t] = __builtin_bit_cast(v4u, __builtin_amdgcn_raw_buffer_load_b128(krs, ko, jc[u] * 4096 + t * 1024, 0)); }
#pragma unroll
                for (int t = 0; t < 4; ++t) { vf[u][t] = __builtin_bit_cast(v4u, __builtin_amdgcn_raw_buffer_load_b128(vrs, vo, jc[u] * 4096 + t * 1024, 0)); } }
            const int nmax = max(nbl[2 * pp], nbl[2 * pp + 1]);
            for (int sb = 0; sb < nmax; ++sb) {
#pragma unroll
                for (int u = 0; u < 2; ++u) { const int gp = 2 * pp + u;
                    const int j = jc[u];
                    const int sn = (sb + 1 < nbl[gp]) ? sb + 1 : nbl[gp] - 1; const int jn = __builtin_amdgcn_readfirstlane((int)blist[gp * 64 + sn]); jc[u] = jn;
                    const bool sel = (sb < nbl[gp]) && ((selm[(4 * gp + qi) * 8 + (j >> 5)] >> (j & 31)) & 1u);
                    const int e0 = opq(t0 + 4 * gp + qi - 64 * j - 4 * g);
                    slc_block4(t0 - (64 * j + 63) >= 127, kf[u], vf[u], qf8[u], e0, sel, lutf, mg[u], lg[u], Og[u], krs, vrs, jn * 4096, ko, vo);
                }
            }
            NSA_FRESH();
            { const int qi2 = q >> 2, hh2 = q & 3;
#pragma unroll
              for (int u = 0; u < 2; ++u) { const int gp = 2 * pp + u; const float lt = xsum4(lg[u]); const float sc = (lt > 0.f ? 1.0f / lt : 0.f) * sigmoidf_(bf2f(Z[(m0 + 4 * gp + qi2) * NINP + ZGT + (kvh * 4 + hh2) * 3 + 1]));
#pragma unroll
                for (int dt = 0; dt < 4; ++dt) { LAS unsigned* tp = (LAS unsigned*)tab; const int slot = ((hh2 * 4 + dt) * 2) * 64 + (4 * gp + qi2) + 16 * g; const unsigned a0 = tp[slot], a1 = tp[slot + 64];
                    tp[slot] = cvtpk(bflo(a0) + Og[u][dt][0] * sc, bfhi(a0) + Og[u][dt][1] * sc); tp[slot + 64] = cvtpk(bflo(a1) + Og[u][dt][2] * sc, bfhi(a1) + Og[u][dt][3] * sc); } } }
        }
        LDS_WAIT(); asm volatile("" ::: "memory");
    }
    NSA_FRESH();
    {
#pragma unroll
        for (int h = 0; h < 4; ++h)
#pragma unroll
            for (int dt = 0; dt < 4; ++dt) O[h][dt] = (f32x4){0.f, 0.f, 0.f, 0.f};
        float m[4] = {-INFINITY, -INFINITY, -INFINITY, -INFINITY}, l[4] = {0.f, 0.f, 0.f, 0.f};
        const unsigned char* KW = F.ws + WS_VTW + (size_t)(b * 4 + kvh) * T * 64;
        const unsigned char* VTW = F.ws + WS_VTW + 8 * MiB + (size_t)(b * 4 + kvh) * T * 64;
        int ks = t0 - 511; ks = ks < 0 ? 0 : (ks & ~31);
        const int kend = t0 + 16;
        v4u kf[2]; v2u vf[4];
        const brsrc krs = mk_rsrc(KW), vrs = mk_rsrc(VTW); const int ko = q * 64 + g * 16, vo = q * 64 + g * 16;
        nsa_ldk8(kf, krs, ks * 64, ko); nsa_ldv8(vf, vrs, (ks >> 6) * 4096 + ((ks & 32) >> 2), vo);
        for (int nb = ks; nb < kend; nb += 32) {
            const int nn = (nb + 32 < kend) ? nb + 32 : nb;
            EfWin ef(nb, g, tq);
            if (t0 - (nb + 31) >= 127 && t0 + 15 - nb <= 511) nsa_step_online8<true>(kf, vf, (const LAS v4u*)(tab + 2048) + lane, ef, lut, true, m, l, O, krs, nn * 64, vrs, (nn >> 6) * 4096 + ((nn & 32) >> 2), ko, vo);
            else nsa_step_online8<false>(kf, vf, (const LAS v4u*)(tab + 2048) + lane, ef, lut, true, m, l, O, krs, nn * 64, vrs, (nn >> 6) * 4096 + ((nn & 32) >> 2), ko, vo);
        }
        bf16* Y = (bf16*)(F.ws + WS_H);
        NSA_FRESH();
#pragma unroll
        for (int h = 0; h < 4; ++h) { const float lt = xsum4(l[h]); const float sc = (lt > 0.f ? 1.0f / lt : 0.f) * sigmoidf_(bf2f(Z[(m0 + q) * NINP + ZGT + (kvh * 4 + h) * 3 + 2]));
#pragma unroll
            for (int dt = 0; dt < 4; ++dt) { const LAS unsigned* tp = (const LAS unsigned*)tab; const unsigned a0 = tp[((h * 4 + dt) * 2 + 0) * 64 + lane], a1 = tp[((h * 4 + dt) * 2 + 1) * 64 + lane];
                v2u w; w.x = cvtpk(bflo(a0) + O[h][dt][0] * sc, bfhi(a0) + O[h][dt][1] * sc); w.y = cvtpk(bflo(a1) + O[h][dt][2] * sc, bfhi(a1) + O[h][dt][3] * sc);
                *(v2u*)(Y + (m0 + q) * D + (kvh * 4 + h) * 64 + 16 * dt + 4 * g) = w; } }
    }
    LDS_WAIT(); asm volatile("" ::: "memory");
#undef NSA_FRESH
}

__device__ __forceinline__ void ph_vtrans(Frame& F) {
    const bf16* Z = (const bf16*)(F.ws + WS_ZA);
    LAS unsigned short* tl = (LAS unsigned short*)(F.lds + F.wave * 8704);
    const int gw = F.bid * NWAVES + F.wave, NGW = F.G * NWAVES;
    for (int it = gw; it < 2 * NB * 4 * 256; it += NGW) {
        const int blk = it & 255, kvh = (it >> 8) & 3, b = (it >> 10) & 1, which = it >> 11;
        const bf16* src = Z + ((size_t)b * T + blk * 64) * NINP + (which ? ZVW : ZVS) + kvh * 64;
        const bf16* ksrc = Z + ((size_t)b * T + blk * 64) * NINP + (which ? ZKW : ZKS) + kvh * 64;
        unsigned char* k8 = F.ws + (which ? WS_VTW : WS_VTS) + ((size_t)(b * 4 + kvh) * T + blk * 64) * 64;
        unsigned char* v8 = k8 + 8 * MiB;
#pragma unroll
        for (int i = 0; i < 8; ++i) { const int tok = i * 8 + (F.lane >> 3), c8 = (F.lane & 7) * 8; const v4u w = *(const v4u*)(src + (size_t)tok * NINP + c8);
            LAS unsigned* p = (LAS unsigned*)(tl + tok * 68 + c8); p[0] = w.x; p[1] = w.y; p[2] = w.z; p[3] = w.w; }
#pragma unroll
        for (int i = 0; i < 8; ++i) { const int tok = i * 8 + (F.lane >> 3), c8 = (F.lane & 7) * 8; const v4u w = *(const v4u*)(ksrc + (size_t)tok * NINP + c8);
            v2u o; o.x = pk_fp8x4(bflo(w.x), bfhi(w.x), bflo(w.y), bfhi(w.y)); o.y = pk_fp8x4(bflo(w.z), bfhi(w.z), bflo(w.w), bfhi(w.w));
            *(v2u*)(k8 + tok * 64 + 16 * ((c8 & 31) >> 3) + 8 * (c8 >> 5)) = o; }
        LDS_WAIT(); asm volatile("" ::: "memory");
#pragma unroll
        for (int i = 0; i < 8; ++i) { const int d = i * 8 + (F.lane >> 3), t8 = (F.lane & 7) * 8; const int kb = ((t8 >> 3) & 1) * 32 + (t8 >> 4) * 4; float e[8];
#pragma unroll
            for (int k = 0; k < 8; ++k) e[k] = __uint_as_float((unsigned)tl[(kb + (k < 4 ? k : 12 + k)) * 68 + d] << 16);
            v2u o; o.x = pk_fp8x4(e[0], e[1], e[2], e[3]); o.y = pk_fp8x4(e[4], e[5], e[6], e[7]);
            *(v2u*)(v8 + d * 64 + t8) = o; }
        LDS_WAIT(); asm volatile("" ::: "memory");
    }
}
#ifndef SCAN_PARTNER
#define SCAN_PARTNER 4
#endif
__device__ __forceinline__ void ph_nsa2_scan(Frame& F, int l) {
    LAS f32x4* lut16 = (LAS f32x4*)F.lds;
    LAS unsigned char* wbase = F.lds + 8192 + ((F.wave + 7) & 7) * 17408;
    LAS float* tab = (LAS float*)wbase; LAS unsigned* selm = (LAS unsigned*)(wbase + 16384); LAS unsigned short* blist = (LAS unsigned short*)(wbase + 16896);
    for (int i = F.tid; i < 512; i += NTHREADS) { const int kvh = i >> 7, d = i & 127; const int bk = rel_bucket_dev(d); const float* tb = F.inp(2);
        lut16[i] = (f32x4){tb[(kvh * 4 + 0) * 32 + bk], tb[(kvh * 4 + 1) * 32 + bk], tb[(kvh * 4 + 2) * 32 + bk], tb[(kvh * 4 + 3) * 32 + bk]} * LOG2E; }
    volatile LAS unsigned* scan_done = (volatile LAS unsigned*)(F.lds + LDS_MISC + 64);
    if (F.tid == 0) *scan_done = 0u;
    __syncthreads();
#ifdef PROBE_SCAN_TWICE
    int nscan = 2; asm volatile("" : "+s"(nscan));
#else
    const int nscan = 1;
#endif
    if (F.wave == 0) { for (int rep = 0; rep < nscan; ++rep) for (int gi = F.bid; gi < 256; gi += F.G) rwkv_scan_v2(F, ((gi & 7) * 2 + ((gi >> 3) >> 4)) * 16 + ((gi >> 3) & 15));
        if (F.lane == 0) *scan_done = 1u; LDS_WAIT(); }
#ifndef SCAN_IDLE_MASK
#define SCAN_IDLE_MASK (1u << SCAN_PARTNER)
#endif
    if ((SCAN_IDLE_MASK >> F.wave) & 1u) { while (*scan_done == 0u) __builtin_amdgcn_s_sleep(64); }
#ifdef PROBE_NSAT
    int ntr = 2; asm volatile("" : "+s"(ntr));
#else
    const int ntr = 1;
#endif
    for (int tr = 0; tr < ntr; ++tr) {
    unsigned* qc = (unsigned*)(F.ws + WS_CTL) + CW_NSAQ + 1024 * (l + 2 * tr); const int xcc = (int)(xb_xcc_id() & 7u);
    for (int y = 0; y < 8; ++y) { const int x = (xcc + y) & 7;
        for (;;) {
            int t = 0;
            if (F.lane == 0) t = (int)__hip_atomic_fetch_add(qc + 64 * x, 1u, __ATOMIC_RELAXED, __HIP_MEMORY_SCOPE_AGENT);
            t = __builtin_amdgcn_readfirstlane(t);
            if (t >= 1024) break;
            nsa2_task(F, t * 8 + x, tab, selm, blist, lut16);
        } }
    }
    if (l < 2) {
        unsigned* qd = (unsigned*)(F.ws + WS_CTL) + CW_NSAQ + 1024 * 6 + 64 * l; const int ndef = (l == 0) ? WC_NDEFER0 : WC_NDEFER1;
        const int ln = lane_id_fresh();
        auto fetch = [&]() { int d = 0; if (ln == 0) d = (int)__hip_atomic_fetch_add(qd, 1u, __ATOMIC_RELAXED, __HIP_MEMORY_SCOPE_AGENT); return __builtin_amdgcn_readfirstlane(d); };
        int d = fetch(); bool have = d < ndef; f32x4 wv[8]; TrJob jb{};
        if (have) { jb = wconv_job(F, wconv_deferred(l, d)); tr_load(jb, ln, wv); }
        while (have) { const int dn = fetch(); const bool haven = dn < ndef; f32x4 wn[8]; TrJob jn = jb;
            if (haven) { jn = wconv_job(F, wconv_deferred(l, dn)); tr_load(jn, ln, wn); }
            tr_finish(jb, wv, tab, ln);
            if (haven) {
#pragma unroll
                for (int i = 0; i < 8; ++i) wv[i] = wn[i]; }
            jb = jn; have = haven; }
    }
}

constexpr int NPL = 16, NPHASES = 2 + DEPTH * NPL;
#ifndef MK_ONE_LAUNCH
#define MK_ONE_LAUNCH 1
#endif
__global__ void __launch_bounds__(NTHREADS, 2) fwd_kernel(Args args) {
    extern __shared__ __attribute__((aligned(16))) unsigned char lds_raw[];
    Frame F;
    F.lds = (LAS unsigned char*)lds_raw; F.wave = __builtin_amdgcn_readfirstlane(threadIdx.x >> 6); asm volatile("" : "+s"(F.wave)); F.lane = lane_id_fresh(); F.tid = F.wave * 64 + F.lane;
    F.G = gridDim.x; F.bid = blockIdx.x; F.out = args.out; F.ws = args.ws;
    F.inl = (const LAS unsigned long long*)(F.lds + LDS_MISC + 256);
    if (F.tid < 29) ((LAS unsigned long long*)(F.lds + LDS_MISC + 256))[F.tid] = (unsigned long long)args.in[F.tid];
    volatile LAS unsigned* MISC = (volatile LAS unsigned*)(F.lds + LDS_MISC);
    if (F.tid < 64) MISC[F.tid] = 0u;
    __syncthreads();
    unsigned* ctl = (unsigned*)(F.ws + WS_CTL);
#if 0
#define IN(p) true
#define USE_BAR true
#else
    const int lo = args.lo, hi = args.hi;
#define IN(p) (lo <= (p) && (p) < hi)
#define USE_BAR (args.use_bar != 0)
#endif
    XcdBarrier bar; bar.bar = ctl + CW_BAR; bar.x = 0; bar.st = nullptr;
    if (USE_BAR) bar = xcd_barrier_post(ctl + CW_BAR, MISC, F.tid);
#define FRESH() do { asm volatile("" : "+s"(F.bid)); asm volatile("" : "+s"(F.G)); asm volatile("" : "+s"(F.ws)); asm volatile("" : "+s"(F.out)); F.lane = lane_id_fresh(); F.tid = F.wave * 64 + F.lane; } while (0)
#define SEAM(p) do { if (IN((p) + 1)) { if (USE_BAR) { F.lane = lane_id_fresh(); F.tid = F.wave * 64 + F.lane; xcd_barrier(bar, F.tid); } } } while (0)
    PG8_LAS unsigned char* glds = (PG8_LAS unsigned char*)lds_raw;
#define Hb ((const pg8::bf16_t*)(F.ws + WS_H))
#define ZAb ((pg8::bf16_t*)(F.ws + WS_ZA))
#define modl ((const float*)(F.ws + WS_MOD) + (size_t)l * NB * MODW)

    if (IN(0)) { FRESH(); ph_prologue(F); SEAM(0); }
    for (int l = 0; l < DEPTH; ++l) {
        const int pb = 1 + NPL * l;
        if (IN(pb + 0)) { FRESH(); if (l == 0) ph_adaln<false>(F, F.inp(0), nullptr, l, 0); else ph_adaln<true>(F, F.out, (const bf16*)(F.ws + WS_H), l, 0); SEAM(pb + 0); }
        if (IN(pb + 1)) { FRESH();
            pg8::Gemm g{Hb, (const pg8::bf16_t*)(F.ws + WS_WGU) + (size_t)(l * 2 + 0) * 2 * FF * D, M, 2 * FF, D}; pg8::StaticOrder S; S.init(M, 2 * FF, F.G, F.bid);
            pg8::EpiSwiGLU E{ZAb, FF};
            pg8::gemm_phase<pg8::EpiSwiGLU, pg8::StaticOrder, true, true>(glds, g, S, E, F.tid);
            SEAM(pb + 1); }
        if (IN(pb + 2)) { FRESH();
            pg8::Gemm g{ZAb, (const pg8::bf16_t*)(F.ws + WS_WD) + (size_t)(l * 2 + 0) * D * FF, M, D, FF}; pg8::StaticOrder S; S.init(M, D, F.G, F.bid);
            pg8::EpiGateBf16<D, MODW, T, 1> E{(pg8::bf16_t*)(F.ws + WS_H), modl + (0 * 3 + 2) * D};
            pg8::gemm_phase<decltype(E), pg8::StaticOrder, true, true>(glds, g, S, E, F.tid);
            SEAM(pb + 2); }
        if (IN(pb + 3)) { FRESH(); ph_adaln<true>(F, (l == 0) ? F.inp(0) : F.out, (const bf16*)(F.ws + WS_H), l, 1); SEAM(pb + 3); }
        if (IN(pb + 4)) { FRESH();
            pg8::Gemm g{Hb, (const pg8::bf16_t*)(F.ws + WS_WIN) + (size_t)l * NINP * D, M, NINP, D}; pg8::StaticOrder S; S.init(M, NINP, F.G, F.bid);
            pg8::EpiPlainBf16 E{ZAb, NINP};
            pg8::gemm_phase<pg8::EpiPlainBf16, pg8::StaticOrder, true, true>(glds, g, S, E, F.tid);
            SEAM(pb + 4); }
#ifndef SKIP_MIXER
#ifdef PROBE_P5
        int p5r = 2; asm volatile("" : "+s"(p5r));
#else
        const int p5r = 1;
#endif
        for (int r5 = 0; r5 < p5r; ++r5)
        if (IN(pb + 5)) { FRESH(); ph_vtrans(F); __syncthreads();
#ifdef PROBE_CMP
            { int cr_ = 2; asm volatile("" : "+s"(cr_)); for (int c_ = 0; c_ < cr_; ++c_) { ph_compress(F, l); __syncthreads(); } }
#else
            ph_compress2(F, l);
#endif
#ifdef PROBE_RW1
            { int rr_ = 2; asm volatile("" : "+s"(rr_)); for (int c_ = 0; c_ < rr_; ++c_) { ph_rwkv2_tok<0>(F, l); __syncthreads(); } }
#else
            ph_rwkv2_tok<0>(F, l);
#endif
            SEAM(pb + 5); }
        if (IN(pb + 6)) {
#ifdef PROBE_NSA_TWICE
            int nrep = 2; asm volatile("" : "+s"(nrep));
#else
            const int nrep = 1;
#endif
            for (int rep = 0; rep < nrep; ++rep) { FRESH(); ph_nsa2_scan(F, l + 2 * rep); __syncthreads(); }
            SEAM(pb + 6); }
        if (IN(pb + 7)) { FRESH(); ph_rwkv2_tok<1>(F, l); SEAM(pb + 7); }
#ifdef PROBE_ML
        int pmr = 2; asm volatile("" : "+s"(pmr));
#else
        const int pmr = 1;
#endif
        for (int rm = 0; rm < pmr; ++rm) {
        if (IN(pb + 8)) { FRESH(); ph_mlA(F, l); SEAM(pb + 9); }
        if (IN(pb + 10)) { FRESH(); ph_mlB(F); SEAM(pb + 10); }
        if (IN(pb + 11)) { FRESH(); ph_mlC(F, l); SEAM(pb + 11); }
        }
        if (IN(pb + 12)) { FRESH();
            pg8::Gemm g{Hb, (const pg8::bf16_t*)(F.ws + WS_WOUT) + (size_t)l * D * D, M, D, D}; pg8::StaticOrder S; S.init(M, D, F.G, F.bid);
            pg8::EpiGateBf16<D, MODW, T, 2> E{(pg8::bf16_t*)(F.ws + WS_ZA), modl + (1 * 3 + 2) * D};
            pg8::gemm_phase<decltype(E), pg8::StaticOrder, true, true>(glds, g, S, E, F.tid);
            SEAM(pb + 12); }
#endif
        if (IN(pb + 13)) { FRESH(); ph_adaln<true>(F, F.out, (const bf16*)(F.ws + WS_ZA), l, 2); SEAM(pb + 13); }
        if (IN(pb + 14)) { FRESH();
            pg8::Gemm g{Hb, (const pg8::bf16_t*)(F.ws + WS_WGU) + (size_t)(l * 2 + 1) * 2 * FF * D, M, 2 * FF, D}; pg8::StaticOrder S; S.init(M, 2 * FF, F.G, F.bid);
            pg8::EpiSwiGLU E{ZAb, FF};
            pg8::gemm_phase<pg8::EpiSwiGLU, pg8::StaticOrder, true, true>(glds, g, S, E, F.tid);
            SEAM(pb + 14); }
        if (IN(pb + 15)) { FRESH();
            pg8::Gemm g{ZAb, (const pg8::bf16_t*)(F.ws + WS_WD) + (size_t)(l * 2 + 1) * D * FF, M, D, FF}; pg8::StaticOrder S; S.init(M, D, F.G, F.bid);
            pg8::EpiGateBf16<D, MODW, T, 1> E{(pg8::bf16_t*)(F.ws + WS_H), modl + (2 * 3 + 2) * D};
            pg8::gemm_phase<decltype(E), pg8::StaticOrder, true, true>(glds, g, S, E, F.tid);
            SEAM(pb + 15); }
    }
    if (IN(NPHASES - 1)) { FRESH(); ph_final(F); }
#undef IN
#undef USE_BAR
#undef SEAM
}

extern "C" void kernel_launch(void* const* d_in, const int* in_sizes, int n_in, void* d_out, int out_size, void* d_ws, size_t ws_size, hipStream_t stream) {
    static int grid = 0;
    if (grid == 0) {
        if (n_in != 29 || in_sizes[0] != M * D || out_size != M * D || ws_size < WS_END3) { fprintf(stderr, "kernel_launch: unexpected problem (n_in %d, in0 %d, out %d, ws %zu < %zu?)\n", n_in, n_in > 0 ? in_sizes[0] : -1, out_size, ws_size, (size_t)WS_END3); grid = -1; return; }
        int dev = 0, cus = 0, per_cu = 0;
        if (hipGetDevice(&dev) != hipSuccess || hipDeviceGetAttribute(&cus, hipDeviceAttributeMultiprocessorCount, dev) != hipSuccess) { grid = -1; return; }
        if (hipFuncSetAttribute((const void*)fwd_kernel, hipFuncAttributeMaxDynamicSharedMemorySize, LDS_BYTES) != hipSuccess) { fprintf(stderr, "kernel_launch: hipFuncSetAttribute failed\n"); grid = -1; return; }
        if (hipOccupancyMaxActiveBlocksPerMultiprocessor(&per_cu, (const void*)fwd_kernel, NTHREADS, LDS_BYTES) != hipSuccess || per_cu < 1) fprintf(stderr, "kernel_launch: occupancy query says %d\n", per_cu);
        (void)hipGetLastError();
        grid = cus;
    }
    if (grid < 0) return;
    if (hipMemsetAsync((char*)d_ws + WS_CTL, 0, CTL_ZERO_BYTES, stream) != hipSuccess) return;
    Args a{};
    for (int i = 0; i < 29; ++i) a.in[i] = (const float*)d_in[i];
    a.out = (float*)d_out; a.ws = (unsigned char*)d_ws; a.pad = 0;
#if MK_ONE_LAUNCH
    a.lo = 0; a.hi = NPHASES; a.use_bar = 1;
    hipLaunchKernelGGL(fwd_kernel, dim3(grid), dim3(NTHREADS), LDS_BYTES, stream, a);
#else
    for (int p = 0; p < NPHASES; ++p) { a.lo = p; a.hi = p + 1; a.use_bar = 0;
        hipLaunchKernelGGL(fwd_kernel, dim3(grid), dim3(NTHREADS), LDS_BYTES, stream, a); }
#endif
}
```

```cpp
#include <hip/hip_runtime.h>
#include <cstdio>
#include <cstdint>
#include <cstddef>
namespace pg8 {
#define PG8_LAS __attribute__((address_space(3)))
typedef unsigned short bf16_t;
typedef short bf16x8 __attribute__((ext_vector_type(8)));
typedef float f32x4 __attribute__((ext_vector_type(4)));
typedef unsigned u32x4 __attribute__((ext_vector_type(4)));
constexpr int BM = 256, BK = 64, HALF = 128, HTB = HALF * BK * 2  , STAGE_BYTES = 8 * HTB, NXCD = 8, WGM = 8;

__host__ __device__ __forceinline__ int lds_byte(int r, int c) { const int st = (r >> 4) * 2 + (c >> 5), rr = r & 15, cc = c & 31, ob = rr * 64 + cc * 2; return st * 1024 + (ob ^ (((ob >> 9) & 1) << 5)); }
__host__ __device__ __forceinline__ void stage_rc(int b, int& R, int& C) { const int st = b / 1024, sb = b % 1024, swz = sb ^ (((sb >> 9) & 1) << 5); R = (st >> 1) * 16 + swz / 64; C = (st & 1) * 32 + (swz % 64) / 2; }
__host__ __device__ __forceinline__ int perm32(int rho) { const int n = rho >> 4, i = rho & 15; return 8 * (i >> 2) + 4 * n + (i & 3); }

struct Unit { int pm, pn; };
struct Gemm { const bf16_t* A; const bf16_t* Bt; int M, N, K; };

struct StaticOrder {
    int nM, nN, nwg, G, c;
    __host__ __device__ void init(int M, int N, int G_, int c_) { nM = M / BM; nN = N / BM; nwg = nM * nN; G = G_; c = c_; }
    __host__ __device__ bool next(int i, Unit& u) const {
        const long L = (long)i * G + c; if (L >= nwg) return false;
        int wgid = (int)L; { const int q = nwg / NXCD, r = nwg % NXCD, xcd = wgid % NXCD, off = wgid / NXCD; wgid = (xcd < r ? xcd * (q + 1) : r * (q + 1) + (xcd - r) * q) + off; }
        const int nig = WGM * nN, gid = wgid / nig, fm = gid * WGM, gsz = (nM - fm) < WGM ? (nM - fm) : WGM;
        u.pm = fm + ((wgid % nig) % gsz); u.pn = (wgid % nig) / gsz; return true;
    }
    __device__ __forceinline__ void a_ready(const Unit&) const {}
    __device__ __forceinline__ void done(const Unit&) const {}
};
__device__ __forceinline__ unsigned cvt_pk_bf16(float lo, float hi) { unsigned r; asm volatile("v_cvt_pk_bf16_f32 %0, %1, %2" : "=v"(r) : "v"(lo), "v"(hi)); return r; }

__device__ __forceinline__ float fast_silu_mul(float g, float u) { const float e = __builtin_amdgcn_exp2f(-1.44269504089f * g); return g * u * __builtin_amdgcn_rcpf(1.0f + e); }
struct EpiPlainBf16 {
    static constexpr bool PERM = true, AFTER_DRAIN = false;
    bf16_t* O; int ldc;
    __device__ __forceinline__ void operator()(const f32x4 (&acc)[2][2][4][2], const Unit& u, int wr, int wc, int fr, int fq) const {
        const int row0 = u.pm * BM + wr * 64 + fr, col0 = u.pn * BM + wc * 32 + 8 * fq;
#pragma unroll
        for (int ai = 0; ai < 2; ++ai)
#pragma unroll
            for (int m = 0; m < 4; ++m) { bf16_t* rowp = O + (size_t)(row0 + ai * HALF + m * 16) * ldc + col0;
#pragma unroll
                for (int bj = 0; bj < 2; ++bj) { const f32x4 v0 = acc[ai][bj][m][0], v1 = acc[ai][bj][m][1];
                    u32x4 w; w.x = cvt_pk_bf16(v0[0], v0[1]); w.y = cvt_pk_bf16(v0[2], v0[3]); w.z = cvt_pk_bf16(v1[0], v1[1]); w.w = cvt_pk_bf16(v1[2], v1[3]);
                    *(u32x4*)(rowp + bj * HALF) = w; } }
    }
};
struct EpiSwiGLU {
    static constexpr bool PERM = true, AFTER_DRAIN = false;
    bf16_t* O; int ldc;
    __device__ __forceinline__ void operator()(const f32x4 (&acc)[2][2][4][2], const Unit& u, int wr, int wc, int fr, int fq) const {
        const int row0 = u.pm * BM + wr * 64 + fr, col0 = u.pn * HALF + wc * 32 + 8 * fq;
#pragma unroll
        for (int ai = 0; ai < 2; ++ai)
#pragma unroll
            for (int m = 0; m < 4; ++m) { bf16_t* rowp = O + (size_t)(row0 + ai * HALF + m * 16) * ldc + col0;
                const f32x4 g0 = acc[ai][0][m][0], g1 = acc[ai][0][m][1], u0 = acc[ai][1][m][0], u1 = acc[ai][1][m][1];
                u32x4 w;
                w.x = cvt_pk_bf16(fast_silu_mul(g0[0], u0[0]), fast_silu_mul(g0[1], u0[1])); w.y = cvt_pk_bf16(fast_silu_mul(g0[2], u0[2]), fast_silu_mul(g0[3], u0[3]));
                w.z = cvt_pk_bf16(fast_silu_mul(g1[0], u1[0]), fast_silu_mul(g1[1], u1[1])); w.w = cvt_pk_bf16(fast_silu_mul(g1[2], u1[2]), fast_silu_mul(g1[3], u1[3]));
                *(u32x4*)rowp = w; }
    }
};
template <int ldc, int gstride, int rows_per_batch, int SCALE_X2> struct EpiGateBf16 {
    static constexpr bool PERM = true, AFTER_DRAIN = false; static constexpr float scale = 0.5f * SCALE_X2;
    bf16_t* O; const float* gate;
    __device__ __forceinline__ void operator()(const f32x4 (&acc)[2][2][4][2], const Unit& u, int wr, int wc, int fr, int fq) const {
        const int row0 = u.pm * BM + wr * 64 + fr, col0 = u.pn * BM + wc * 32 + 8 * fq;
        const int b = (u.pm * BM) / rows_per_batch;
#pragma unroll
        for (int bj = 0; bj < 2; ++bj) { const float* gp = gate + (size_t)b * gstride + col0 + bj * HALF; const f32x4 g0 = *(const f32x4*)gp * scale, g1 = *(const f32x4*)(gp + 4) * scale;
#pragma unroll
            for (int ai = 0; ai < 2; ++ai)
#pragma unroll
                for (int m = 0; m < 4; ++m) { bf16_t* rowp = O + (size_t)(row0 + ai * HALF + m * 16) * ldc + col0 + bj * HALF;
                    const f32x4 v0 = acc[ai][bj][m][0] * g0, v1 = acc[ai][bj][m][1] * g1;
                    u32x4 w; w.x = cvt_pk_bf16(v0[0], v0[1]); w.y = cvt_pk_bf16(v0[2], v0[3]); w.z = cvt_pk_bf16(v1[0], v1[1]); w.w = cvt_pk_bf16(v1[2], v1[3]);
                    *(u32x4*)rowp = w; } }
    }
};
struct EpiResid {
    static constexpr bool PERM = false, AFTER_DRAIN = false;
    const float* base; float* out; int ldc; const float* gate; int gstride; int rows_per_batch; float scale;
    __device__ __forceinline__ void operator()(const f32x4 (&acc)[2][2][4][2], const Unit& u, int wr, int wc, int fr, int fq) const {
        const int row0 = u.pm * BM + wr * 64 + fr, col0 = u.pn * BM + wc * 32 + 4 * fq;
        const int b = (u.pm * BM) / rows_per_batch;
        f32x4 gv[2][2];
#pragma unroll
        for (int bj = 0; bj < 2; ++bj)
#pragma unroll
            for (int n = 0; n < 2; ++n) gv[bj][n] = *(const f32x4*)(gate + (size_t)b * gstride + col0 + bj * HALF + n * 16) * scale;
#pragma unroll
        for (int ai = 0; ai < 2; ++ai)
#pragma unroll
            for (int m = 0; m < 4; ++m) { const size_t off = (size_t)(row0 + ai * HALF + m * 16) * ldc + col0;
#pragma unroll
                for (int bj = 0; bj < 2; ++bj)
#pragma unroll
                    for (int n = 0; n < 2; ++n) { const f32x4 bs = *(const f32x4*)(base + off + bj * HALF + n * 16);
                        *(f32x4*)(out + off + bj * HALF + n * 16) = bs + acc[ai][bj][m][n] * gv[bj][n]; } }
    }
};
template <class Epi, class Sched, bool ALIGN_EPI = false, bool SP2 = false>
__device__ __forceinline__ void gemm_phase(PG8_LAS unsigned char* lds, const Gemm g, const Sched& S, const Epi& E, const int tid) {
    const int wid = __builtin_amdgcn_readfirstlane(tid >> 6), lane = tid & 63, wr = wid >> 2, wc = wid & 3, fr = lane & 15, fq = lane >> 4;
    const int K = g.K, nt = K / BK;
    unsigned voffA[2], voffB[2];
#pragma unroll
    for (int i = 0; i < 2; ++i) { int R, C; stage_rc(tid * 16 + i * 8192, R, C); const int Rb = Epi::PERM ? ((R & ~31) + perm32(R & 31)) : R;
        voffA[i] = (unsigned)(R * K + C) * 2u; voffB[i] = (unsigned)(Rb * K + C) * 2u; }
    const size_t kstep = (size_t)(BK * 2);
    const size_t hstep = (size_t)HALF * K * 2;
    const size_t tstep = 2 * hstep;
    const unsigned ldsw = (unsigned)wid * 1024u;
    const int aoff = lds_byte(wr * 64 + fr, fq * 8), boff = lds_byte(wc * 32 + fr, fq * 8);
#define PG8_SA(b, h) (((b) * 2 + (h)) * HTB)
#define PG8_SB(b, h) ((4 + (b) * 2 + (h)) * HTB)
#define PG8_STAGE(bufoff, gbase, voff) do { _Pragma("unroll") for (int _i = 0; _i < 2; ++_i) \
        __builtin_amdgcn_global_load_lds((const unsigned*)((const char*)(gbase) + (voff)[_i]), (PG8_LAS unsigned*)(lds + (bufoff) + ldsw + _i * 8192), 16, 0, 0); } while (0)
#define PG8_LDA(dst, b, h) do { _Pragma("unroll") for (int m = 0; m < 4; ++m) _Pragma("unroll") for (int k = 0; k < 2; ++k) dst[m][k] = *(const PG8_LAS bf16x8*)(lds + PG8_SA(b, h) + aoff + m * 2048 + k * 1024); } while (0)
#define PG8_LDB(dst, b, h) do { _Pragma("unroll") for (int n = 0; n < 2; ++n) _Pragma("unroll") for (int k = 0; k < 2; ++k) dst[n][k] = *(const PG8_LAS bf16x8*)(lds + PG8_SB(b, h) + boff + n * 2048 + k * 1024); } while (0)
#define PG8_MMA(ai, bj, At, Bt) do { __builtin_amdgcn_s_setprio(1); _Pragma("unroll") for (int m = 0; m < 4; ++m) _Pragma("unroll") for (int n = 0; n < 2; ++n) _Pragma("unroll") for (int k = 0; k < 2; ++k) \
        acc[ai][bj][m][n] = __builtin_amdgcn_mfma_f32_16x16x32_bf16(Bt[n][k], At[m][k], acc[ai][bj][m][n], 0, 0, 0); __builtin_amdgcn_s_setprio(0); } while (0)
#define PG8_WAIT_V(n) asm volatile("s_waitcnt vmcnt(" #n ")" ::: "memory")
#define PG8_WAIT_L(n) asm volatile("s_waitcnt lgkmcnt(" #n ")" ::: "memory")
#define PG8_BAR __builtin_amdgcn_s_barrier()
#define PG8_SCHED __builtin_amdgcn_sched_barrier(0)
    Unit cur, nxt; int ui = 0;
    if (!S.next(0, cur)) return;
    f32x4 acc[2][2][4][2];
#pragma unroll
    for (int a = 0; a < 2; ++a)
#pragma unroll
        for (int b = 0; b < 2; ++b)
#pragma unroll
            for (int m = 0; m < 4; ++m)
#pragma unroll
                for (int n = 0; n < 2; ++n) acc[a][b][m][n] = (f32x4){0.f, 0.f, 0.f, 0.f};
    bf16x8 At[4][2], B0[2][2], B1[2][2];
    const char* cA = (const char*)g.A + (size_t)cur.pm * tstep; const char* cB = (const char*)g.Bt + (size_t)cur.pn * tstep;
    S.a_ready(cur);
    if constexpr (SP2) {
        PG8_STAGE(PG8_SB(0, 0), cB, voffB); PG8_STAGE(PG8_SB(0, 1), cB + hstep, voffB); PG8_STAGE(PG8_SA(0, 0), cA, voffA); PG8_STAGE(PG8_SA(0, 1), cA + hstep, voffA);
        if (wr == 1) PG8_BAR;
        PG8_WAIT_V(2); PG8_BAR;
        PG8_STAGE(PG8_SB(1, 0), cB + kstep, voffB); PG8_STAGE(PG8_SA(1, 0), cA + kstep, voffA); PG8_STAGE(PG8_SB(1, 1), cB + hstep + kstep, voffB);
        PG8_WAIT_V(6); PG8_BAR;
    } else {
        PG8_STAGE(PG8_SB(0, 0), cB, voffB); PG8_STAGE(PG8_SA(0, 0), cA, voffA); PG8_STAGE(PG8_SB(0, 1), cB + hstep, voffB); PG8_STAGE(PG8_SA(0, 1), cA + hstep, voffA);
        if (wr == 1) PG8_BAR;
        PG8_WAIT_V(4); PG8_BAR;
        PG8_STAGE(PG8_SB(1, 0), cB + kstep, voffB); PG8_STAGE(PG8_SA(1, 0), cA + kstep, voffA); PG8_STAGE(PG8_SB(1, 1), cB + hstep + kstep, voffB);
        PG8_WAIT_V(6); PG8_BAR;
    }
    for (;;) {
        const bool has_next = S.next(ui + 1, nxt);
        const char* nA = has_next ? (const char*)g.A + (size_t)nxt.pm * tstep : cA; const char* nB = has_next ? (const char*)g.Bt + (size_t)nxt.pn * tstep : cB;
        for (int t = 0; t < nt; t += 2) {
            const bool last = (t == nt - 2);
            const char* a1 = cA + (size_t)(t + 1) * kstep;
            const char* a2 = last ? nA : cA + (size_t)(t + 2) * kstep; const char* b2 = last ? nB : cB + (size_t)(t + 2) * kstep;
            const char* a3 = a2 + kstep; const char* b3 = b2 + kstep;
            if (last && has_next) S.a_ready(nxt);
            if constexpr (SP2) {
            PG8_LDB(B0, 0, 0); PG8_LDB(B1, 0, 1); PG8_SCHED; PG8_LDA(At, 0, 0); PG8_STAGE(PG8_SA(1, 1), a1 + hstep, voffA);
            PG8_WAIT_V(8); PG8_WAIT_L(0); PG8_BAR; PG8_MMA(0, 0, At, B0); PG8_MMA(0, 1, At, B1); PG8_BAR; PG8_SCHED;
            PG8_LDA(At, 0, 1); PG8_STAGE(PG8_SB(0, 0), b2, voffB); PG8_STAGE(PG8_SB(0, 1), b2 + hstep, voffB); PG8_STAGE(PG8_SA(0, 0), a2, voffA);
            PG8_WAIT_V(8); PG8_WAIT_L(0); PG8_BAR; PG8_MMA(1, 0, At, B0); PG8_MMA(1, 1, At, B1); PG8_BAR; PG8_SCHED;
            PG8_LDB(B0, 1, 0); PG8_LDB(B1, 1, 1); PG8_SCHED; PG8_LDA(At, 1, 0); PG8_STAGE(PG8_SA(0, 1), a2 + hstep, voffA);
            PG8_WAIT_V(8); PG8_WAIT_L(0); PG8_BAR; PG8_MMA(0, 0, At, B0); PG8_MMA(0, 1, At, B1); PG8_BAR; PG8_SCHED;
            PG8_LDA(At, 1, 1); PG8_STAGE(PG8_SB(1, 0), b3, voffB); PG8_STAGE(PG8_SB(1, 1), b3 + hstep, voffB); PG8_STAGE(PG8_SA(1, 0), a3, voffA);
            PG8_WAIT_V(8); PG8_WAIT_L(0); PG8_BAR; PG8_MMA(1, 0, At, B0); PG8_MMA(1, 1, At, B1); PG8_BAR; PG8_SCHED;
            } else {
            PG8_LDB(B0, 0, 0); PG8_SCHED; PG8_LDA(At, 0, 0); PG8_STAGE(PG8_SA(1, 1), a1 + hstep, voffA);
            PG8_WAIT_L(8); PG8_BAR; PG8_WAIT_L(0); PG8_MMA(0, 0, At, B0); PG8_BAR; PG8_SCHED;
            PG8_LDB(B1, 0, 1); PG8_STAGE(PG8_SB(0, 0), b2, voffB);
            PG8_BAR; PG8_WAIT_L(0); PG8_MMA(0, 1, At, B1); PG8_BAR;
            PG8_LDA(At, 0, 1); PG8_STAGE(PG8_SA(0, 0), a2, voffA);
            PG8_BAR; PG8_WAIT_L(0); PG8_MMA(1, 0, At, B0); PG8_BAR; PG8_SCHED;
            PG8_STAGE(PG8_SB(0, 1), b2 + hstep, voffB);
            PG8_WAIT_V(6); PG8_BAR; PG8_MMA(1, 1, At, B1); PG8_BAR;
            PG8_LDB(B0, 1, 0); PG8_SCHED; PG8_LDA(At, 1, 0); PG8_STAGE(PG8_SA(0, 1), a2 + hstep, voffA);
            PG8_WAIT_L(8); PG8_BAR; PG8_WAIT_L(0); PG8_MMA(0, 0, At, B0); PG8_BAR; PG8_SCHED;
            PG8_LDB(B1, 1, 1); PG8_STAGE(PG8_SB(1, 0), b3, voffB);
            PG8_BAR; PG8_WAIT_L(0); PG8_MMA(0, 1, At, B1); PG8_BAR;
            PG8_LDA(At, 1, 1); PG8_STAGE(PG8_SA(1, 0), a3, voffA);
            PG8_BAR; PG8_WAIT_L(0); PG8_MMA(1, 0, At, B0); PG8_BAR; PG8_SCHED;
            PG8_STAGE(PG8_SB(1, 1), b3 + hstep, voffB);
            PG8_WAIT_V(6); PG8_BAR; PG8_MMA(1, 1, At, B1); PG8_BAR;
            }
        }
        if constexpr (ALIGN_EPI) { if (wr == 0) PG8_BAR; }
        if constexpr (!Epi::AFTER_DRAIN) { E(acc, cur, wr, wc, fr, fq); S.done(cur); }
        if (!has_next) break;
#pragma unroll
        for (int a = 0; a < 2; ++a)
#pragma unroll
            for (int b = 0; b < 2; ++b)
#pragma unroll
                for (int m = 0; m < 4; ++m)
#pragma unroll
                    for (int n = 0; n < 2; ++n) acc[a][b][m][n] = (f32x4){0.f, 0.f, 0.f, 0.f};
        cur = nxt; cA = nA; cB = nB; ++ui;
        if constexpr (ALIGN_EPI) { if (wr == 1) PG8_BAR; }
    }
    PG8_WAIT_V(0);
    if constexpr (!ALIGN_EPI) { if (wr == 0) PG8_BAR; }
    PG8_BAR;
    if constexpr (Epi::AFTER_DRAIN) { E.fused(acc, cur, wr, wc, fr, fq, lds, wid, lane); S.done(cur); }
#undef PG8_SA
#undef PG8_SB
#undef PG8_STAGE
#undef PG8_LDA
#undef PG8_LDB
#undef PG8_MMA
#undef PG8_WAIT_V
#undef PG8_WAIT_L
#undef PG8_BAR
#undef PG8_SCHED
}
}

constexpr int NB = 2, T = 16384, M = NB * T, D = 2048, FF = 5632, NIN = 6456, NINP = 6656, DEPTH = 2, MODW = 9 * D;
constexpr int ZQ = 0, ZKC = 1024, ZVC = 1280, ZKS = 1536, ZVS = 1792, ZKW = 2048, ZVW = 2304, ZGT = 2560;
constexpr int ZMQ = 2608, ZMK = 3120, ZMV = 3632, ZMO = 4144, ZMI = 4656, ZMF = 4660;
constexpr int ZRW = 4664, RWC = 1792;
constexpr int YML = 1024, YRW = 1536;
constexpr int NWAVES = 8, NTHREADS = 512;

constexpr size_t MiB = (size_t)1 << 20;
constexpr size_t WS_CTL = 0, CTL_ZERO_BYTES = 64 * 1024;
constexpr size_t WS_MOD = 1 * MiB;
constexpr size_t WS_KC = 2 * MiB, WS_VC = 3 * MiB;
constexpr size_t WS_MLF = 4 * MiB;
constexpr size_t WS_MLI = 4 * MiB + 512 * 1024;
constexpr size_t WS_MLG = 5 * MiB;
constexpr size_t WS_MLNP = 6 * MiB;
constexpr size_t WS_MLNS = 7 * MiB;
constexpr size_t WS_WGU = 10 * MiB;
constexpr size_t WS_WD = 186 * MiB;
constexpr size_t WS_WIN = 274 * MiB;
constexpr size_t WS_WOUT = 326 * MiB;
constexpr size_t WS_H = 342 * MiB;
constexpr size_t WS_ZA = 470 * MiB;
constexpr size_t WS_MIX = 886 * MiB;
constexpr size_t WS_END = 1142 * MiB;
constexpr size_t MX_RR = 0, MX_RK = 32 * MiB, MX_RV = 64 * MiB, MX_RN = 96 * MiB, MX_RA = 128 * MiB, MX_RWW = 160 * MiB;
constexpr size_t MX_MQ = 0, MX_MK = 32 * MiB, MX_U = 64 * MiB, MX_CT = 192 * MiB;

constexpr int CW_BAR = 1024;

#define GAS __attribute__((address_space(1)))
#define LAS __attribute__((address_space(3)))
typedef unsigned short bf16;
typedef float f32x4 __attribute__((ext_vector_type(4)));
typedef float f32x2 __attribute__((ext_vector_type(2)));
typedef unsigned v4u __attribute__((ext_vector_type(4)));
typedef unsigned v2u __attribute__((ext_vector_type(2)));
__device__ __forceinline__ float bf2f(unsigned short b) { return __uint_as_float(((unsigned)b) << 16); }
__device__ __forceinline__ float bflo(unsigned w) { return __uint_as_float(w << 16); }
__device__ __forceinline__ float bfhi(unsigned w) { return __uint_as_float(w & 0xffff0000u); }
__device__ __forceinline__ unsigned f2bf(float f) { unsigned u = __float_as_uint(f); return (u + 0x7fffu + ((u >> 16) & 1u)) >> 16; }
__device__ __forceinline__ unsigned pk2(float lo, float hi) { return f2bf(lo) | (f2bf(hi) << 16); }
template <int CTRL> __device__ __forceinline__ float dpp_mov(float v) { return __int_as_float(__builtin_amdgcn_update_dpp(0, __float_as_int(v), CTRL, 0xF, 0xF, false)); }
__device__ __forceinline__ float rdlane(float v, int l) { return __int_as_float(__builtin_amdgcn_readlane(__float_as_int(v), l)); }
__device__ __forceinline__ float wave_sum(float v) {
    v += dpp_mov<0xB1>(v); v += dpp_mov<0x4E>(v); v += dpp_mov<0x141>(v); v += dpp_mov<0x140>(v);
    return (rdlane(v, 0) + rdlane(v, 16)) + (rdlane(v, 32) + rdlane(v, 48));
}
__device__ __forceinline__ float wave_max(float v) {
    v = fmaxf(v, dpp_mov<0xB1>(v)); v = fmaxf(v, dpp_mov<0x4E>(v)); v = fmaxf(v, dpp_mov<0x141>(v)); v = fmaxf(v, dpp_mov<0x140>(v));
    return fmaxf(fmaxf(rdlane(v, 0), rdlane(v, 16)), fmaxf(rdlane(v, 32), rdlane(v, 48)));
}
__device__ __forceinline__ float swz16(float v) { return __int_as_float(__builtin_amdgcn_ds_swizzle(__float_as_int(v), 0x401F)); }
__device__ __forceinline__ int swz16i(int v) { return __builtin_amdgcn_ds_swizzle(v, 0x401F); }
__device__ __forceinline__ int opq(int x) { asm volatile("" : "+v"(x)); return x; }
__device__ __forceinline__ unsigned cvtpk(float lo, float hi) { unsigned r; asm volatile("v_cvt_pk_bf16_f32 %0, %1, %2" : "=v"(r) : "v"(lo), "v"(hi)); return r; }
typedef short bf16x8 __attribute__((ext_vector_type(8)));
#define MFMA16(a, b, c) __builtin_amdgcn_mfma_f32_16x16x32_bf16((a), (b), (c), 0, 0, 0)
__device__ __forceinline__ float xmax4(float x) { const auto s = __builtin_amdgcn_permlane16_swap(__float_as_uint(x), __float_as_uint(x), false, false); x = fmaxf(__uint_as_float(s[0]), __uint_as_float(s[1]));
    const auto t = __builtin_amdgcn_permlane32_swap(__float_as_uint(x), __float_as_uint(x), false, false); return fmaxf(__uint_as_float(t[0]), __uint_as_float(t[1])); }
__device__ __forceinline__ float xsum4(float x) { const auto s = __builtin_amdgcn_permlane16_swap(__float_as_uint(x), __float_as_uint(x), false, false); x = __uint_as_float(s[0]) + __uint_as_float(s[1]);
    const auto t = __builtin_amdgcn_permlane32_swap(__float_as_uint(x), __float_as_uint(x), false, false); return __uint_as_float(t[0]) + __uint_as_float(t[1]); }
__device__ __forceinline__ float bperm(float v, int srclane) { return __int_as_float(__builtin_amdgcn_ds_bpermute(srclane << 2, __float_as_int(v))); }
__device__ __forceinline__ float wave_prefix_sum(float v, int lane) {
#pragma unroll
    for (int d = 1; d < 64; d <<= 1) { const float o = bperm(v, (lane - d) & 63); if (lane >= d) v += o; }
    return v; }
__device__ __forceinline__ float wave_prefix_max(float v, int lane) {
#pragma unroll
    for (int d = 1; d < 64; d <<= 1) { const float o = bperm(v, (lane - d) & 63); if (lane >= d) v = fmaxf(v, o); }
    return v; }
__device__ __forceinline__ float sigmoidf_(float x) { return __builtin_amdgcn_rcpf(1.0f + __expf(-x)); }
__device__ __forceinline__ float siluf_(float x) { return x * __builtin_amdgcn_rcpf(1.0f + __expf(-x)); }
__device__ __forceinline__ float logsigmoidf_(float x) { return fminf(x, 0.f) - __logf(1.0f + __expf(-fabsf(x))); }
__device__ __forceinline__ float softplusf_(float x) { return fmaxf(x, 0.f) + __logf(1.0f + __expf(-fabsf(x))); }

#define XB_TMO      128
#define XB_XCNT(j)  (256  + 64 * (j))
#define XB_XSUB(j)  (1280 + 64 * (j))
#define XB_XGEN(j)  (2304 + 64 * (j))
#define XB_TOP      3328
#define XB_TOPGEN   3392
#define XCD_BAR_WORDS 3456
#define XB_SPIN_CAP (1u << 18)
__device__ __forceinline__ unsigned xb_ld(unsigned* p)              { return __hip_atomic_load(p, __ATOMIC_RELAXED, __HIP_MEMORY_SCOPE_AGENT); }
__device__ __forceinline__ unsigned xb_add(unsigned* p, unsigned v) { return __hip_atomic_fetch_add(p, v, __ATOMIC_RELAXED, __HIP_MEMORY_SCOPE_AGENT); }
__device__ __forceinline__ unsigned xb_xcc_id() { return (unsigned)__builtin_amdgcn_s_getreg((3 << 11) | 20) & 0xFu; }
#define XB_SPIN(cond, bar) do { unsigned _sp = 0; while (cond) { __builtin_amdgcn_s_sleep(1); \
    if ((++_sp & 255u) == 0u) { if (xb_ld(&(bar)[XB_TMO])) break; if (_sp > XB_SPIN_CAP) { atomicAdd(&(bar)[XB_TMO], 1u); break; } } } } while (0)
struct XcdBarrier { unsigned* bar; unsigned x; volatile LAS unsigned* st; };
__device__ __forceinline__ XcdBarrier xcd_barrier_post(unsigned* bar, volatile LAS unsigned* st, int tid) {
    XcdBarrier b; b.bar = bar; b.x = xb_xcc_id(); b.st = st;
    if (tid == 0) (void)xb_add(&bar[XB_XCNT(b.x)], 1u);
    return b;
}
__device__ __forceinline__ void xcd_barrier_complete(unsigned* bar, unsigned x, unsigned& nloc, unsigned& nx) {
    const unsigned G = gridDim.x * gridDim.y * gridDim.z;
    unsigned sum, cnt, mine, sp = 0u;
    for (;;) {
        sum = 0u; cnt = 0u; mine = 0u;
#pragma unroll
        for (unsigned j = 0; j < 16; ++j) { const unsigned c = xb_ld(&bar[XB_XCNT(j)]); sum += c; cnt += (c > 0u) ? 1u : 0u; mine = (j == x) ? c : mine; }
        if (sum == G) break;
        __builtin_amdgcn_s_sleep(1);
        if ((++sp & 255u) == 0u) { if (xb_ld(&bar[XB_TMO])) break; if (sp > XB_SPIN_CAP) { atomicAdd(&bar[XB_TMO], 1u); break; } }
    }
    nloc = mine > 0u ? mine : 1u; nx = cnt > 0u ? cnt : 1u;
}
__device__ __forceinline__ void xcd_barrier(const XcdBarrier& b, int tid) {
    asm volatile("s_waitcnt vmcnt(0)" ::: "memory");
    __syncthreads();
    if (tid == 0) {
        unsigned* bar = b.bar;
        __builtin_amdgcn_s_waitcnt(0);
        unsigned nloc = b.st[0], nx = b.st[1];
        if (nloc == 0u) { xcd_barrier_complete(bar, b.x, nloc, nx); b.st[0] = nloc; b.st[1] = nx; }
        const unsigned old = xb_add(&bar[XB_XSUB(b.x)], 1u);
        const unsigned gen = old / nloc;
        if (old + 1u == (gen + 1u) * nloc) {
            __builtin_amdgcn_fence(__ATOMIC_RELEASE, "agent");
            asm volatile("s_waitcnt vmcnt(0)" ::: "memory");
            const unsigned og = xb_add(&bar[XB_TOP], 1u);
            const unsigned tg = og / nx;
            if (og + 1u == (tg + 1u) * nx) xb_add(&bar[XB_TOPGEN], 1u);
            else XB_SPIN(xb_ld(&bar[XB_TOPGEN]) == tg, bar);
            __builtin_amdgcn_fence(__ATOMIC_ACQUIRE, "agent");
            xb_add(&bar[XB_XGEN(b.x)], 1u);
            asm volatile("s_waitcnt vmcnt(0)" ::: "memory");
        } else {
            XB_SPIN(xb_ld(&bar[XB_XGEN(b.x)]) == gen, bar);
            __builtin_amdgcn_fence(__ATOMIC_ACQUIRE, "agent");
            asm volatile("s_waitcnt vmcnt(0)" ::: "memory");
        }
    }
    __syncthreads();
}

constexpr int LDS_BYTES = 163328;
constexpr int LDS_MISC = 163328 - 512;
struct Args { const float* in[29]; float* out; unsigned char* ws; int lo, hi, use_bar, pad; };
struct Frame {
    LAS unsigned char* lds; int tid, lane, wave, G, bid;
    const LAS unsigned long long* inl; float* out; unsigned char* ws;
    __device__ __forceinline__ const float* inp(int i) const { const unsigned long long v = inl[i];
        const unsigned lo = __builtin_amdgcn_readfirstlane((unsigned)v), hi = __builtin_amdgcn_readfirstlane((unsigned)(v >> 32));
        return (const float*)(((unsigned long long)hi << 32) | lo); }
};
#define LDS_WAIT() asm volatile("s_waitcnt lgkmcnt(0)" ::: "memory")
__device__ __forceinline__ int lane_id_fresh() { int l; asm volatile("v_mbcnt_lo_u32_b32 %0, -1, 0\n\tv_mbcnt_hi_u32_b32 %0, -1, %0" : "=v"(l)); return l; }

__device__ __forceinline__ void tr_item(const float* W, int K, int N, bf16* WT, int dst_row0, int k0, int n0, LAS float* scr, int lane) {
#pragma unroll
    for (int i = 0; i < 8; ++i) { const int kk = 8 * i + (lane >> 3), nl = (lane & 7) * 4, n = n0 + nl;
        f32x4 w = {0.f, 0.f, 0.f, 0.f}; if (n < N) w = *(const f32x4*)(W + (size_t)(k0 + kk) * N + n);
        LAS float* d = scr + kk * 33 + nl; d[0] = w.x; d[1] = w.y; d[2] = w.z; d[3] = w.w; }
    LDS_WAIT(); asm volatile("" ::: "memory");
    const int c = lane & 7;
#pragma unroll
    for (int j = 0; j < 4; ++j) { const int n = (lane >> 3) + 8 * j; const LAS float* s = scr + (8 * c) * 33 + n;
        v4u o; o.x = cvtpk(s[0 * 33], s[1 * 33]); o.y = cvtpk(s[2 * 33], s[3 * 33]); o.z = cvtpk(s[4 * 33], s[5 * 33]); o.w = cvtpk(s[6 * 33], s[7 * 33]);
        *(v4u*)(WT + (size_t)(dst_row0 + n) * K + k0 + 8 * c) = o; }
    LDS_WAIT(); asm volatile("" ::: "memory");
}
constexpr int WC_IG = (D / 64) * (FF / 32), WC_ID = (FF / 64) * (D / 32), WC_IIN = (D / 64) * (NINP / 32), WC_IOUT = (D / 64) * (D / 32);
constexpr int WC_NEARLY = 2 * WC_IG + WC_ID + WC_IIN, WC_NDEFER = 6 * WC_IG + 3 * WC_ID + WC_IIN + 2 * WC_IOUT;
__device__ __forceinline__ void wconv_item(Frame& F, int it, LAS float* scr, int lane) {
    constexpr int I_G = WC_IG, I_D = WC_ID, I_IN = WC_IIN, I_OUT = WC_IOUT;
    bf16* WGU = (bf16*)(F.ws + WS_WGU); bf16* WD = (bf16*)(F.ws + WS_WD); bf16* WIN = (bf16*)(F.ws + WS_WIN); bf16* WOUT = (bf16*)(F.ws + WS_WOUT);
    int r = it;
    if (r < 8 * I_G) {
        const int mat = r / I_G, ls = mat & 3, isup = mat >> 2; r -= mat * I_G;
        const int nblk = FF / 32, kb = r / nblk, nb = r % nblk, n0 = 32 * nb;
        const float* W = (isup ? F.inp(8) : F.inp(7)) + (size_t)ls * D * FF;
        tr_item(W, D, FF, WGU + (size_t)ls * 2 * FF * D, (n0 / 128) * 256 + (n0 % 128) + isup * 128, 64 * kb, n0, scr, lane);
        return; }
    r -= 8 * I_G;
    if (r < 4 * I_D) { const int ls = r / I_D; r -= ls * I_D; const int nblk = D / 32, kb = r / nblk, nb = r % nblk;
        tr_item(F.inp(9) + (size_t)ls * FF * D, FF, D, WD + (size_t)ls * D * FF, 32 * nb, 64 * kb, 32 * nb, scr, lane); return; }
    r -= 4 * I_D;
    if (r < 2 * I_IN) { const int l = r / I_IN; r -= l * I_IN; const int nblk = NINP / 32, kb = r / nblk, nb = r % nblk;
        tr_item(F.inp(10) + (size_t)l * D * NIN, D, NIN, WIN + (size_t)l * NINP * D, 32 * nb, 64 * kb, 32 * nb, scr, lane); return; }
    r -= 2 * I_IN;
    { const int l = r / I_OUT; r -= l * I_OUT; const int nblk = D / 32, kb = r / nblk, nb = r % nblk;
        tr_item(F.inp(11) + (size_t)l * D * D, D, D, WOUT + (size_t)l * D * D, 32 * nb, 64 * kb, 32 * nb, scr, lane); }
}
__device__ __forceinline__ int wconv_early(int e) {
    if (e < WC_IG) return e;
    if (e < 2 * WC_IG) return 4 * WC_IG + (e - WC_IG);
    if (e < 2 * WC_IG + WC_ID) return 8 * WC_IG + (e - 2 * WC_IG);
    return 8 * WC_IG + 4 * WC_ID + (e - 2 * WC_IG - WC_ID);
}
constexpr int WC_NDEFER0 = 4 * WC_IG + 2 * WC_ID + WC_IIN + WC_IOUT, WC_NDEFER1 = 2 * WC_IG + WC_ID + WC_IOUT;
static_assert(WC_NDEFER0 + WC_NDEFER1 == WC_NDEFER, "deferred lots");
__device__ __forceinline__ int wconv_deferred(int lot, int d) {
    if (lot == 0) {
        if (d < 4 * WC_IG) { const int m4 = d / WC_IG; const int mat = (m4 < 2) ? m4 + 1 : m4 + 3; return mat * WC_IG + (d - m4 * WC_IG); }
        d -= 4 * WC_IG;
        if (d < 2 * WC_ID) return 8 * WC_IG + WC_ID + d;
        d -= 2 * WC_ID;
        if (d < WC_IIN) return 8 * WC_IG + 4 * WC_ID + WC_IIN + d;
        d -= WC_IIN;
        return 8 * WC_IG + 4 * WC_ID + 2 * WC_IIN + d;
    }
    if (d < 2 * WC_IG) { const int m2 = d / WC_IG; const int mat = m2 ? 7 : 3; return mat * WC_IG + (d - m2 * WC_IG); }
    d -= 2 * WC_IG;
    if (d < WC_ID) return 8 * WC_IG + 3 * WC_ID + d;
    d -= WC_ID;
    return 8 * WC_IG + 4 * WC_ID + 2 * WC_IIN + WC_IOUT + d;
}
__device__ __forceinline__ void ph_prologue(Frame& F) {
    LAS float* scr = (LAS float*)(F.lds + F.wave * 16384);
    const int gw = F.bid * NWAVES + F.wave, NGW = F.G * NWAVES;
    for (int e = gw; e < WC_NEARLY; e += NGW) wconv_item(F, wconv_early(e), scr, F.lane);
    {
        unsigned char* sw = F.ws + (size_t)1174 * MiB;
        constexpr int NS = 2 * (16 + 16 + 32) + 4 * 128 + 4 * 4;
        for (int it = gw; it < NS; it += NGW) {
            int r = it;
            if (r < 128) { const int l = r / 64; r -= l * 64;
                if (r < 16) tr_item(F.inp(21) + (size_t)l * 64 * 512, 64, 512, (bf16*)sw + (size_t)l * 512 * 64, 32 * r, 0, 32 * r, scr, F.lane);
                else if (r < 32) { r -= 16; tr_item(F.inp(23) + (size_t)l * 64 * 512, 64, 512, (bf16*)(sw + 128 * 1024) + (size_t)l * 512 * 64, 32 * r, 0, 32 * r, scr, F.lane); }
                else { r -= 32; tr_item(F.inp(24) + (size_t)l * 128 * 512, 128, 512, (bf16*)(sw + 256 * 1024) + (size_t)l * 512 * 128, 32 * (r & 15), 64 * (r >> 4), 32 * (r & 15), scr, F.lane); }
                continue; }
            r -= 128;
            if (r < 512) { const int lk = r / 128; r -= lk * 128; tr_item(F.inp(13) + (size_t)lk * 2048 * 128, 2048, 128, (bf16*)(sw + 512 * 1024) + (size_t)lk * 128 * 2048, 32 * (r & 3), 64 * (r >> 2), 32 * (r & 3), scr, F.lane); continue; }
            r -= 512;
            { const int lk = r / 4; r -= lk * 4; tr_item(F.inp(14) + (size_t)lk * 128 * 64, 128, 64, (bf16*)(sw + 512 * 1024 + 4 * 512 * 1024) + (size_t)lk * 64 * 128, 32 * (r & 1), 64 * (r >> 1), 32 * (r & 1), scr, F.lane); }
        }
    }
    __syncthreads();
    if (F.bid < 4) {
        LAS float* red = (LAS float*)F.lds; const int lk = F.bid, j = F.tid & 127, part = F.tid >> 7;
        const float* w1 = F.inp(13) + (size_t)lk * 2048 * 128; const float* pos = F.inp(12) + (size_t)lk * 2048; float s = 0.f;
        for (int kk = 0; kk < 512; ++kk) { const int k = part * 512 + kk; s += pos[k] * w1[(size_t)k * 128 + j]; }
        red[part * 128 + j] = s; __syncthreads();
        if (F.tid < 128) ((float*)(F.ws + (size_t)1179 * MiB))[lk * 128 + j] = red[j] + red[128 + j] + red[256 + j] + red[384 + j];
        __syncthreads();
    }
    {
        float* mod = (float*)(F.ws + WS_MOD);
        LAS f32x4* red = (LAS f32x4*)F.lds;
        const int tx = F.tid & 15, ty = F.tid >> 4;
        for (int it = F.bid; it < DEPTH * (MODW / 64); it += F.G) {
            const int l = it / (MODW / 64), n0 = (it % (MODW / 64)) * 64 + 4 * tx;
            const float* W = F.inp(4) + (size_t)l * D * MODW + n0;
            f32x4 a0 = {0.f, 0.f, 0.f, 0.f}, a1 = {0.f, 0.f, 0.f, 0.f};
            for (int kk = 0; kk < 64; ++kk) { const int k = ty * 64 + kk; const f32x4 w = *(const f32x4*)(W + (size_t)k * MODW);
                const float c0 = siluf_(F.inp(1)[k]), c1 = siluf_(F.inp(1)[D + k]); a0 += w * c0; a1 += w * c1; }
            red[(ty * 16 + tx) * 2 + 0] = a0; red[(ty * 16 + tx) * 2 + 1] = a1;
            __syncthreads();
            if (F.tid < 128) { const int b = F.tid >> 6, col = F.tid & 63; float s = 0.f;
                for (int y = 0; y < 32; ++y) s += red[(y * 16 + (col >> 2)) * 2 + b][col & 3];
                const int n = (it % (MODW / 64)) * 64 + col;
                mod[((size_t)l * NB + b) * MODW + n] = s + F.inp(5)[(size_t)l * MODW + n]; }
            __syncthreads();
        }
    }
}

template <bool DELTA> __device__ __forceinline__ void ph_adaln(Frame& F, const float* xin, const bf16* dl, int l, int sub) {
    LAS float* A = (LAS float*)F.lds; LAS float* Bv = A + NB * D;
    const float* mod = (const float*)(F.ws + WS_MOD) + (size_t)l * NB * MODW;
    const float* g = F.inp(6) + ((size_t)l * 3 + sub) * D;
    for (int i = F.tid; i < NB * D; i += NTHREADS) { const int b = i / D, d = i % D;
        A[i] = g[d] * (1.0f + mod[(size_t)b * MODW + (sub * 3 + 1) * D + d]); Bv[i] = mod[(size_t)b * MODW + (sub * 3 + 0) * D + d]; }
    __syncthreads();
    bf16* H = (bf16*)(F.ws + WS_H);
    const int gw = F.bid * NWAVES + F.wave, NGW = F.G * NWAVES;
    for (int m = gw; m < M; m += NGW) {
        const int b = m / T;
        const f32x4* xr = (const f32x4*)(xin + (size_t)m * D) + F.lane;
        f32x4 v[8]; float ss = 0.f;
#pragma unroll
        for (int j = 0; j < 8; ++j) v[j] = __builtin_nontemporal_load(&xr[64 * j]);
        if (DELTA) { const v2u* dr = (const v2u*)(dl + (size_t)m * D) + F.lane; f32x4* xo = (f32x4*)(F.out + (size_t)m * D) + F.lane;
#pragma unroll
            for (int j = 0; j < 8; ++j) { const v2u w = dr[64 * j]; v[j] += (f32x4){bflo(w.x), bfhi(w.x), bflo(w.y), bfhi(w.y)}; __builtin_nontemporal_store(v[j], &xo[64 * j]); } }
#pragma unroll
        for (int j = 0; j < 8; ++j) ss += (v[j].x * v[j].x + v[j].y * v[j].y) + (v[j].z * v[j].z + v[j].w * v[j].w);
        const float rstd = 1.0f / sqrtf(wave_sum(ss) * (1.0f / D) + 1e-6f);
        v2u* o8 = (v2u*)(H + (size_t)m * D) + F.lane;
#pragma unroll
        for (int j = 0; j < 8; ++j) { const int e = b * D + 4 * F.lane + 256 * j; const f32x4 a = *(const LAS f32x4*)(A + e), s = *(const LAS f32x4*)(Bv + e);
            const f32x4 y = v[j] * rstd * a + s; v2u w; w.x = pk2(y.x, y.y); w.y = pk2(y.z, y.w); o8[64 * j] = w; }
    }
    __syncthreads();
}
__device__ __forceinline__ void ph_final(Frame& F) {
    const float* g = F.inp(3);
    const int gw = F.bid * NWAVES + F.wave, NGW = F.G * NWAVES;
    for (int m = gw; m < M; m += NGW) {
        f32x4* xr = (f32x4*)(F.out + (size_t)m * D) + F.lane;
        const v2u* dr = (const v2u*)((const bf16*)(F.ws + WS_H) + (size_t)m * D) + F.lane;
        f32x4 v[8]; float ss = 0.f;
#pragma unroll
        for (int j = 0; j < 8; ++j) { const v2u w = dr[64 * j]; v[j] = xr[64 * j] + (f32x4){bflo(w.x), bfhi(w.x), bflo(w.y), bfhi(w.y)}; ss += (v[j].x * v[j].x + v[j].y * v[j].y) + (v[j].z * v[j].z + v[j].w * v[j].w); }
        const float rstd = 1.0f / sqrtf(wave_sum(ss) * (1.0f / D) + 1e-6f);
#pragma unroll
        for (int j = 0; j < 8; ++j) { const f32x4 gg = *((const f32x4*)g + F.lane + 64 * j); xr[64 * j] = v[j] * rstd * gg; }
    }
}

__device__ __forceinline__ int rel_bucket_dev(int d) {
    if (d < 16) return d;
    const int large = 16 + (int)(logf((float)d * (1.0f / 16.0f)) / 2.0794415416798357f * 16.0f);
    return large < 31 ? large : 31;
}

__device__ __forceinline__ void ph_compress(Frame& F, int l) {
    const bf16* Z = (const bf16*)(F.ws + WS_ZA);
    LAS float* tok = (LAS float*)F.lds;
    LAS float* red = tok + 144 * 64;
    LAS float* hid = red + 4 * 8 * 128;
    const int j = F.tid & 127, part = F.tid >> 7;
    for (int it = F.bid; it < 2 * NB * 4 * 128; it += F.G) {
        const int grp = it & 127, kvh = (it >> 7) & 3, b = (it >> 9) & 1, kv = it >> 10;
        const int t0 = grp * 128;
        const bf16* zc = Z + (size_t)(b * T) * NINP + (kv ? ZVC : ZKC) + kvh * 64;
        for (int i = F.tid; i < 144 * 64; i += NTHREADS) { const int tt = t0 + (i >> 6); tok[i] = (tt < T) ? bf2f(zc[(size_t)tt * NINP + (i & 63)]) : 0.f; }
        __syncthreads();
        const float* w1 = F.inp(13) + ((size_t)l * 2 + kv) * 2048 * 128;
        const float* pos = F.inp(12) + ((size_t)l * 2 + kv) * 32 * 64;
        float acc[8], accp = 0.f;
#pragma unroll
        for (int i = 0; i < 8; ++i) acc[i] = 0.f;
        for (int kk = 0; kk < 512; ++kk) { const int k = part * 512 + kk, r = k >> 6, d = k & 63; const float w = w1[(size_t)k * 128 + j];
            accp += pos[k] * w;
#pragma unroll
            for (int i = 0; i < 8; ++i) acc[i] += tok[(16 * i + r) * 64 + d] * w; }
#pragma unroll
        for (int i = 0; i < 8; ++i) red[(part * 8 + i) * 128 + j] = acc[i] + accp;
        __syncthreads();
        for (int i = F.tid; i < 8 * 128; i += NTHREADS) { const float s = red[i] + red[1024 + i] + red[2048 + i] + red[3072 + i]; hid[i] = siluf_(s); }
        __syncthreads();
        { const int ii = F.tid >> 6, d = F.tid & 63; const float* w2 = F.inp(14) + ((size_t)l * 2 + kv) * 128 * 64; float s = 0.f;
          for (int q = 0; q < 128; ++q) s += hid[ii * 128 + q] * w2[q * 64 + d];
          if (kv) ((bf16*)(F.ws + WS_VC))[((size_t)(b * 4 + kvh) * 64 + d) * 1024 + grp * 8 + ii] = (bf16)f2bf(s);
          else ((bf16*)(F.ws + WS_KC))[((size_t)(b * 4 + kvh) * 1024 + grp * 8 + ii) * 64 + d] = (bf16)f2bf(s); }
        __syncthreads();
    }
}

template <int MODE> __device__ __forceinline__ void ph_rwkv_tok(Frame& F, int l) {
    const bf16* Z = (const bf16*)(F.ws + WS_ZA);
    LAS float* zs = (LAS float*)F.lds;
    LAS float* th = zs + RWC;
    LAS float* sg = th + 64;
    const float* mu = F.inp(19) + (size_t)l * RWC; const float* w0 = F.inp(20) + (size_t)l * 512; const float* w_up = F.inp(21) + (size_t)l * 64 * 512;
    const float* a0 = F.inp(22) + (size_t)l * 512; const float* a_up = F.inp(23) + (size_t)l * 64 * 512; const float* g_up = F.inp(24) + (size_t)l * 128 * 512;
    const float* k_k = F.inp(25) + (size_t)l * 512; const float* k_a = F.inp(26) + (size_t)l * 512; const float* r_k = F.inp(27) + (size_t)l * 512;
    const float* ln0 = F.inp(28) + (size_t)l * 2 * 512; const float* ln1 = ln0 + 512;
    unsigned char* mx = F.ws + WS_MIX;
    bf16* RR = (bf16*)(mx + MX_RR); bf16* RK = (bf16*)(mx + MX_RK); bf16* RV = (bf16*)(mx + MX_RV); bf16* RN = (bf16*)(mx + MX_RN); bf16* RA = (bf16*)(mx + MX_RA); float* RW = (float*)(mx + MX_RWW);
    bf16* Y = (bf16*)(F.ws + WS_H);
    const int c = F.tid;
    for (int m = F.bid; m < M; m += F.G) {
        const int t = m % T;
        const bf16* zr = Z + (size_t)m * NINP + ZRW;
        for (int i = F.tid; i < RWC; i += NTHREADS) { const float zc = bf2f(zr[i]); const float zp = (t > 0) ? bf2f(zr[i - NINP]) : 0.f; zs[i] = zc + mu[i] * (zp - zc); }
        __syncthreads();
        if (F.tid < 64) th[F.tid] = tanhf(zs[1536 + F.tid]);
        else if (F.tid < 192) sg[F.tid - 64] = sigmoidf_(zs[1664 + F.tid - 64]);
        __syncthreads();
        const float r = zs[c], k = zs[512 + c], v = zs[1024 + c];
        float ws_ = w0[c], as_ = a0[c];
        for (int q = 0; q < 64; ++q) { ws_ += th[q] * w_up[q * 512 + c]; as_ += zs[1600 + q] * a_up[q * 512 + c]; }
        const float a = sigmoidf_(as_);
        const float kp = k * (1.0f + (a - 1.0f) * k_a[c]);
        if (MODE == 0) {
            const float w_log = -softplusf_(-ws_) - 0.5f; const float decay = expf(-expf(w_log));
            float kk = k * k_k[c]; const float nrm = sqrtf(wave_sum(kk * kk)); kk = kk / fmaxf(nrm, 1e-12f);
            const size_t o = (size_t)m * 512 + c;
            RR[o] = (bf16)f2bf(r); RK[o] = (bf16)f2bf(kp); RV[o] = (bf16)f2bf(v); RN[o] = (bf16)f2bf(kk); RA[o] = (bf16)f2bf(a); RW[o] = decay;
        } else {
            float g = 0.f;
            for (int q = 0; q < 128; ++q) g += sg[q] * g_up[q * 512 + c];
            const float rb = bf2f((bf16)f2bf(r)), kb = bf2f((bf16)f2bf(kp)), vb = bf2f((bf16)f2bf(v));
            const float bonus = wave_sum(rb * kb * r_k[c]);
            const float y = bf2f(Y[(size_t)m * D + YRW + c]);
            const float mu_ = wave_sum(y) * (1.0f / 64.0f); const float dy = y - mu_; const float var = wave_sum(dy * dy) * (1.0f / 64.0f);
            float o = dy * (1.0f / sqrtf(var + 64e-5f)) * ln0[c] + ln1[c];
            o += bonus * vb;
            Y[(size_t)m * D + YRW + c] = (bf16)f2bf(o * g);
        }
        __syncthreads();
    }
}

__device__ __forceinline__ void rwkv_scan_row(Frame& F, int rid) {
    unsigned char* mx = F.ws + WS_MIX;
    const bf16* __restrict__ RR = (const bf16*)(mx + MX_RR); const bf16* __restrict__ RK = (const bf16*)(mx + MX_RK); const bf16* __restrict__ RV = (const bf16*)(mx + MX_RV);
    const bf16* __restrict__ RN = (const bf16*)(mx + MX_RN); const bf16* __restrict__ RA = (const bf16*)(mx + MX_RA); const float* __restrict__ RW = (const float*)(mx + MX_RWW);
    bf16* __restrict__ Y = (bf16*)(F.ws + WS_H);
    const int i = rid & 63, h = (rid >> 6) & 7, b = rid >> 9;
    const size_t base = (size_t)(b * T) * 512 + h * 64;
    float S = 0.f;
    for (int t = 0; t < T; t += 4) {
        float r[4], w[4], k[4], n[4], a[4], v[4];
#pragma unroll
        for (int u = 0; u < 4; ++u) { const size_t o = base + (size_t)(t + u) * 512 + F.lane;
            r[u] = bf2f(RR[o]); w[u] = RW[o]; k[u] = bf2f(RK[o]); n[u] = bf2f(RN[o]); a[u] = bf2f(RA[o]); v[u] = bf2f(RV[base + (size_t)(t + u) * 512 + i]); }
#pragma unroll
        for (int u = 0; u < 4; ++u) {
            const float sa = wave_sum(S * (-n[u]));
            S = S * w[u] + sa * (n[u] * a[u]) + v[u] * k[u];
            const float y = wave_sum(S * r[u]);
            if (F.lane == 0) Y[(size_t)(b * T + t + u) * D + YRW + h * 64 + i] = (bf16)f2bf(y);
        }
    }
}

__device__ __forceinline__ void ph_ml0(Frame& F, int l) {
    const bf16* Z = (const bf16*)(F.ws + WS_ZA);
    bf16* MQ = (bf16*)(F.ws + WS_MIX + MX_MQ); bf16* MK = (bf16*)(F.ws + WS_MIX + MX_MK);
    float* LF = (float*)(F.ws + WS_MLF); float* LI = (float*)(F.ws + WS_MLI);
    const float* cw = F.inp(15) + (size_t)l * 4 * 1024; const float* cb = F.inp(16) + (size_t)l * 1024; const float* gb = F.inp(17) + (size_t)l * 8;
    for (int m = F.bid; m < M; m += F.G) {
        const int t = m % T, b = m / T;
        for (int c = F.tid; c < 1024; c += NTHREADS) {
            float s = cb[c];
#pragma unroll
            for (int j = 0; j < 4; ++j) { const int tt = t - 3 + j; if (tt >= 0) s += cw[j * 1024 + c] * bf2f(Z[(size_t)(m - 3 + j) * NINP + ZMQ + c]); }
            s = siluf_(s);
            if (c < 512) MQ[(size_t)m * 512 + c] = (bf16)f2bf(s); else MK[(size_t)m * 512 + c - 512] = (bf16)f2bf(s * 0.08838834764831845f);
        }
        if (F.tid < 4) { const int h = F.tid; LI[(size_t)(b * 4 + h) * T + t] = bf2f(Z[(size_t)m * NINP + ZMI + h]) + gb[h];
            LF[(size_t)(b * 4 + h) * T + t] = logsigmoidf_(bf2f(Z[(size_t)m * NINP + ZMF + h]) + gb[4 + h]); }
    }
}
__device__ __forceinline__ void ph_ml1(Frame& F) {
    const bf16* Z = (const bf16*)(F.ws + WS_ZA);
    const bf16* MK = (const bf16*)(F.ws + WS_MIX + MX_MK);
    const float* LF = (const float*)(F.ws + WS_MLF); const float* LI = (const float*)(F.ws + WS_MLI);
    float* G_ = (float*)(F.ws + WS_MLG); float* A_ = G_ + 2048;
    float* U = (float*)(F.ws + WS_MIX + MX_U); float* NP = (float*)(F.ws + WS_MLNP);
    LAS float* kf = (LAS float*)F.lds; LAS float* vf = kf + 64 * 128; LAS float* wv = vf + 64 * 128; LAS float* bc = wv + 64;
    for (int it = F.bid; it < 2048; it += F.G) {
        const int bh = it >> 8, ck = it & 255, b = bh >> 2, h = bh & 3; const size_t m0 = (size_t)b * T + ck * 64;
        for (int i = F.tid; i < 64 * 128; i += NTHREADS) { const int s = i >> 7, d = i & 127; kf[i] = bf2f(MK[(m0 + s) * 512 + h * 128 + d]); vf[i] = bf2f(Z[(m0 + s) * NINP + ZMV + h * 128 + d]); }
        if (F.tid == 0) { float cum = 0.f; for (int s = 0; s < 64; ++s) { cum += LF[(size_t)bh * T + ck * 64 + s]; bc[s] = cum; }
            const float g = cum; float a = -INFINITY; for (int s = 0; s < 64; ++s) { const float lw = g - bc[s] + LI[(size_t)bh * T + ck * 64 + s]; wv[s] = lw; a = fmaxf(a, lw); }
            for (int s = 0; s < 64; ++s) wv[s] = __expf(wv[s] - a); G_[it] = g; A_[it] = a; }
        __syncthreads();
        { const int dk = F.tid & 127, dv0 = F.tid >> 7; float acc[32];
#pragma unroll
          for (int q = 0; q < 32; ++q) acc[q] = 0.f;
          float np = 0.f;
          for (int s = 0; s < 64; ++s) { const float kv = wv[s] * kf[s * 128 + dk]; np += kv;
#pragma unroll
              for (int q = 0; q < 32; ++q) acc[q] += vf[s * 128 + dv0 + 4 * q] * kv; }
#pragma unroll
          for (int q = 0; q < 32; ++q) U[(size_t)it * 16384 + (size_t)(dv0 + 4 * q) * 128 + dk] = acc[q];
          if (dv0 == 0) NP[(size_t)it * 128 + dk] = np; }
        __syncthreads();
    }
}
__device__ __forceinline__ void ph_ml2(Frame& F) {
    const float* G_ = (const float*)(F.ws + WS_MLG); const float* A_ = G_ + 2048; float* M_ = (float*)(F.ws + WS_MLG) + 4096;
    const float* U = (const float*)(F.ws + WS_MIX + MX_U); bf16* CT = (bf16*)(F.ws + WS_MIX + MX_CT);
    const float* NP = (const float*)(F.ws + WS_MLNP); float* NS = (float*)(F.ws + WS_MLNS);
    for (int gid = F.bid * NTHREADS + F.tid; gid < 8 * 16384; gid += F.G * NTHREADS) {
        const int bh = gid >> 14, e = gid & 16383;
        float C = 0.f, n = 0.f, m = 0.f;
        for (int k = 0; k < 256; ++k) { const int it = bh * 256 + k;
            CT[(size_t)it * 16384 + e] = (bf16)f2bf(C);
            if (e < 128) NS[(size_t)it * 128 + e] = n;
            if (e == 0) M_[it] = m;
            const float g = G_[it], a = A_[it]; const float mn = fmaxf(g + m, a); const float dec = __expf(g + m - mn), ee = __expf(a - mn);
            C = dec * C + ee * U[(size_t)it * 16384 + e];
            if (e < 128) n = dec * n + ee * NP[(size_t)it * 128 + e];
            m = mn; }
    }
}
__device__ __forceinline__ void ph_ml3(Frame& F, int l) {
    const bf16* Z = (const bf16*)(F.ws + WS_ZA);
    const bf16* MQ = (const bf16*)(F.ws + WS_MIX + MX_MQ); const bf16* MK = (const bf16*)(F.ws + WS_MIX + MX_MK);
    const float* LF = (const float*)(F.ws + WS_MLF); const float* LI = (const float*)(F.ws + WS_MLI);
    const float* M_ = (const float*)(F.ws + WS_MLG) + 4096; const bf16* CT = (const bf16*)(F.ws + WS_MIX + MX_CT); const float* NS = (const float*)(F.ws + WS_MLNS);
    const float* gn = F.inp(18) + (size_t)l * 512;
    bf16* Y = (bf16*)(F.ws + WS_H);
    LAS float* qf = (LAS float*)F.lds;
    LAS float* kf = qf + 64 * 128;
    LAS float* vf = kf + 64 * 129;
    LAS float* Sm = vf + 64 * 128;
    LAS float* Hb = Sm + 64 * 65;
    LAS float* bc = Hb + 64 * 128;
    LAS float* ig = bc + 64; LAS float* mt = ig + 64; LAS float* wi = mt + 64; LAS float* den = wi + 64;
    for (int it = F.bid; it < 2048; it += F.G) {
        const int bh = it >> 8, ck = it & 255, b = bh >> 2, h = bh & 3; const size_t m0 = (size_t)b * T + ck * 64;
        const float mprev = M_[it];
        for (int i = F.tid; i < 64 * 128; i += NTHREADS) { const int s = i >> 7, d = i & 127;
            qf[i] = bf2f(MQ[(m0 + s) * 512 + h * 128 + d]); kf[s * 129 + d] = bf2f(MK[(m0 + s) * 512 + h * 128 + d]); vf[i] = bf2f(Z[(m0 + s) * NINP + ZMV + h * 128 + d]); }
        if (F.tid == 0) { float cum = 0.f; for (int s = 0; s < 64; ++s) { cum += LF[(size_t)bh * T + ck * 64 + s]; bc[s] = cum; ig[s] = LI[(size_t)bh * T + ck * 64 + s]; } }
        __syncthreads();
        if (F.tid < 64) { const int t = F.tid; float mxv = bc[t] + mprev; for (int s = 0; s <= t; ++s) mxv = fmaxf(mxv, bc[t] - bc[s] + ig[s]); mt[t] = mxv; wi[t] = __expf(bc[t] + mprev - mxv); }
        __syncthreads();
        for (int r = 0; r < 8; ++r) { const int idx = F.tid + 512 * r, t = idx >> 6, s = idx & 63; float v = 0.f;
            if (s <= t) { float dsum = 0.f; for (int d = 0; d < 128; ++d) dsum += qf[t * 128 + d] * kf[s * 129 + d]; v = dsum * __expf(bc[t] - bc[s] + ig[s] - mt[t]); }
            Sm[t * 65 + s] = v; }
        __syncthreads();
        if (F.tid < 64) { const int t = F.tid; float s1 = 0.f; for (int s = 0; s < 64; ++s) s1 += Sm[t * 65 + s]; float qn = 0.f; for (int d = 0; d < 128; ++d) qn += qf[t * 128 + d] * NS[(size_t)it * 128 + d];
            den[t] = s1 + wi[t] * qn; }
        __syncthreads();
        for (int r = 0; r < 16; ++r) { const int idx = F.tid + 512 * r, t = idx >> 7, dv = idx & 127;
            float a1 = 0.f; for (int s = 0; s < 64; ++s) a1 += Sm[t * 65 + s] * vf[s * 128 + dv];
            float a2 = 0.f; const bf16* cr = CT + (size_t)it * 16384 + (size_t)dv * 128; for (int d = 0; d < 128; ++d) a2 += qf[t * 128 + d] * bf2f(cr[d]);
            const float num = a1 + wi[t] * a2; const float hh = num / fmaxf(fabsf(den[t]), __expf(-mt[t]));
            const float og = sigmoidf_(bf2f(Z[(m0 + t) * NINP + ZMO + h * 128 + dv]));
            Hb[t * 128 + dv] = og * hh; }
        __syncthreads();
        for (int r = 0; r < 8; ++r) { const int t = F.wave * 8 + r; const float x0 = Hb[t * 128 + F.lane], x1 = Hb[t * 128 + 64 + F.lane];
            const float mu = wave_sum(x0 + x1) * (1.0f / 128.0f); const float d0 = x0 - mu, d1 = x1 - mu; const float var = wave_sum(d0 * d0 + d1 * d1) * (1.0f / 128.0f); const float rs = 1.0f / sqrtf(var + 1e-6f);
            Y[(m0 + t) * D + YML + h * 128 + F.lane] = (bf16)f2bf(d0 * rs * gn[h * 128 + F.lane]); Y[(m0 + t) * D + YML + h * 128 + 64 + F.lane] = (bf16)f2bf(d1 * rs * gn[h * 128 + 64 + F.lane]); }
        __syncthreads();
    }
}

constexpr size_t WS_SW = 1174 * MiB;
constexpr size_t SW_WUP = 0, SW_AUP = 128 * 1024, SW_GUP = 256 * 1024, SW_W1T = 512 * 1024, SW_W2T = SW_W1T + 4 * 512 * 1024, SW_END = SW_W2T + 4 * 16 * 1024;
constexpr size_t WS_BON = 1178 * MiB;
constexpr size_t WS_PB = 1179 * MiB;
constexpr size_t WS_END3 = 1180 * MiB;
#ifndef SCAN_R_
#define SCAN_R_ 32
#endif
constexpr int SCAN_R = SCAN_R_;
typedef float v2f __attribute__((ext_vector_type(2)));
constexpr int SCAN_YSTAGE_OFF = 8192 + 3 * 17408;
constexpr int SCAN_RING_OFF = 8192 + 7 * 17408;
constexpr int ACT_LD = 136;

template <class TT> __device__ __forceinline__ TT ldg(const void* ubase, unsigned off) { return *(const GAS TT*)((const GAS char*)ubase + off); }
template <class TT> __device__ __forceinline__ void stg(void* ubase, unsigned off, TT v) { *(GAS TT*)((GAS char*)ubase + off) = v; }
__device__ __forceinline__ unsigned pkh2(float a, float b);
__device__ __forceinline__ float h2f_lo(unsigned w) { return (float)__builtin_bit_cast(_Float16, (unsigned short)(w & 0xffffu)); }
__device__ __forceinline__ float h2f_hi(unsigned w) { return (float)__builtin_bit_cast(_Float16, (unsigned short)(w >> 16)); }
__device__ __forceinline__ void ph_compress2(Frame& F, int l) {
    const bf16* Z = (const bf16*)(F.ws + WS_ZA);
    LAS unsigned short* hl = (LAS unsigned short*)F.lds;
    const int lane = F.lane, tk = lane & 15, g = lane >> 4, w = F.wave;
    for (int it = F.bid; it < 2 * NB * 4 * 64; it += F.G) {
        const int grp = it & 63, kvh = (it >> 6) & 3, b = (it >> 8) & 1, kv = it >> 9; const int lk = l * 2 + kv;
        const unsigned z0 = (unsigned)opq(0);
        const bf16* W1T = (const bf16*)(F.ws + WS_SW + SW_W1T) + (size_t)lk * 128 * 2048 + (size_t)w * 16 * 2048;
        const int i0 = grp * 16;
        const bf16* zc = Z + ((size_t)b * T + 16 * i0) * NINP + (kv ? ZVC : ZKC) + kvh * 64;
        const unsigned aoff = (unsigned)(tk * 2048 + 8 * g) * 2u + z0;
        const unsigned boff = (unsigned)(tk * 16 * NINP + 8 * g) * 2u + z0;
        const int tokbase = 16 * (i0 + tk);
        f32x4 acc = {0.f, 0.f, 0.f, 0.f};
        for (int k8 = 0; k8 < 64; k8 += 8) {
            bf16x8 af[8], bfv[8];
#pragma unroll
            for (int u = 0; u < 8; ++u) { const int ks = k8 + u; af[u] = ldg<bf16x8>(W1T, aoff + 64u * ks);
                const int tok = tokbase + (ks >> 1); v4u bw = {0u, 0u, 0u, 0u};
                if (tok < T) bw = ldg<v4u>(zc, boff + (unsigned)((ks >> 1) * NINP + 32 * (ks & 1)) * 2u);
                bfv[u] = __builtin_bit_cast(bf16x8, bw); }
#pragma unroll
            for (int u = 0; u < 8; ++u) acc = MFMA16(af[u], bfv[u], acc);
        }
        { const f32x4 pb = ldg<f32x4>(F.ws + WS_PB, (unsigned)(lk * 128 + w * 16 + 4 * g) * 4u + z0);
          v2u hv; hv.x = pk2(siluf_(acc[0] + pb[0]), siluf_(acc[1] + pb[1])); hv.y = pk2(siluf_(acc[2] + pb[2]), siluf_(acc[3] + pb[3]));
          *(LAS v2u*)(hl + tk * 136 + w * 16 + 4 * g) = hv; }
        __syncthreads();
        if (w < 4) {
            const bf16* W2T = (const bf16*)(F.ws + WS_SW + SW_W2T) + (size_t)lk * 64 * 128 + (size_t)w * 16 * 128;
            f32x4 o = {0.f, 0.f, 0.f, 0.f};
#pragma unroll
            for (int ks = 0; ks < 4; ++ks) { const bf16x8 a2 = ldg<bf16x8>(W2T, (unsigned)(tk * 128 + 8 * g + 32 * ks) * 2u + z0); const bf16x8 b2 = *(const LAS bf16x8*)(hl + tk * 136 + 32 * ks + 8 * g); o = MFMA16(a2, b2, o); }
            const int n = i0 + tk;
            if (kv == 0) { v2u ov; ov.x = pk2(o[0], o[1]); ov.y = pk2(o[2], o[3]);
                stg<v2u>(F.ws + WS_KC, (unsigned)(((b * 4 + kvh) * 1024 + n) * 64 + w * 16 + 4 * g) * 2u + z0, ov); }
            else {
#pragma unroll
                for (int r = 0; r < 4; ++r) stg<unsigned short>(F.ws + WS_VC, (unsigned)(((b * 4 + kvh) * 64 + w * 16 + 4 * g + r) * 1024 + n) * 2u + z0, (unsigned short)f2bf(o[r])); }
        }
        __syncthreads();
    }
}
template <int MODE> __device__ __forceinline__ void ph_rwkv2_tok(Frame& F, int l) {
    const bf16* Z = (const bf16*)(F.ws + WS_ZA);
    LAS unsigned short* act = (LAS unsigned short*)F.lds;
    const float* mu = F.inp(19) + (size_t)l * RWC;
    const int lane = F.lane, tk = lane & 15, g = lane >> 4, h = F.wave;
    const bf16* WUP = (const bf16*)(F.ws + WS_SW + SW_WUP) + (size_t)l * 512 * 64 + (size_t)h * 64 * 64;
    const bf16* AUP = (const bf16*)(F.ws + WS_SW + SW_AUP) + (size_t)l * 512 * 64 + (size_t)h * 64 * 64;
    const bf16* GUP = (const bf16*)(F.ws + WS_SW + SW_GUP) + (size_t)l * 512 * 128 + (size_t)h * 64 * 128;
    unsigned char* REC = F.ws + WS_MIX;
    float* BON = (float*)(F.ws + WS_BON);
    bf16* Y = (bf16*)(F.ws + WS_H);
    const unsigned choff_ = (unsigned)(h * 64 + 4 * g) * 4u;
    const float* pw0 = F.inp(20) + (size_t)l * 512; const float* pa0 = F.inp(22) + (size_t)l * 512; const float* pkk = F.inp(25) + (size_t)l * 512;
    const float* pka = F.inp(26) + (size_t)l * 512; const float* prk = F.inp(27) + (size_t)l * 512; const float* pln = F.inp(28) + (size_t)l * 1024;
    for (int tt = F.bid; tt < M / 64; tt += F.G) {
        const size_t m0 = (size_t)tt * 64; const int t0 = (int)(m0 % T);
        for (int i = F.tid; i < 64 * 32; i += NTHREADS) { const int tok = i >> 5, c4 = (i & 31) * 4; const int t = t0 + tok;
            const int col = (MODE == 0 ? 1536 : 1664) + c4;
            const bf16* zr = Z + m0 * NINP + ZRW; const unsigned zo = (unsigned)(tok * NINP + col) * 2u;
            const v2u zc = ldg<v2u>(zr, zo); v2u zp = {0u, 0u}; if (t > 0) zp = ldg<v2u>(zr - NINP, zo);
            const f32x4 mm = ldg<f32x4>(mu, (unsigned)col * 4u);
            float x[4] = {bflo(zc.x), bfhi(zc.x), bflo(zc.y), bfhi(zc.y)}; const float p[4] = {bflo(zp.x), bfhi(zp.x), bflo(zp.y), bfhi(zp.y)};
#pragma unroll
            for (int e = 0; e < 4; ++e) { x[e] = x[e] + mm[e] * (p[e] - x[e]); if (MODE == 0) { if (c4 < 64) x[e] = tanhf(x[e]); } else x[e] = sigmoidf_(x[e]); }
            LAS unsigned* d = (LAS unsigned*)(act + tok * ACT_LD + c4); d[0] = pk2(x[0], x[1]); d[1] = pk2(x[2], x[3]); }
        __syncthreads();
        for (int mt = 0; mt < 4; ++mt) {

            const unsigned z0 = (unsigned)opq(0);
            const unsigned choff = choff_ + z0;
            bf16x8 wa[4][4];
#pragma unroll
            for (int nt = 0; nt < 4; ++nt) {
                if (MODE == 0) { const unsigned o = (unsigned)((nt * 16 + tk) * 64 + 8 * g) * 2u + z0;
                    wa[nt][0] = ldg<bf16x8>(WUP, o); wa[nt][1] = ldg<bf16x8>(WUP, o + 64u); wa[nt][2] = ldg<bf16x8>(AUP, o); wa[nt][3] = ldg<bf16x8>(AUP, o + 64u); }
                else { const unsigned o = (unsigned)((nt * 16 + tk) * 128 + 8 * g) * 2u + z0;
#pragma unroll
                    for (int ks = 0; ks < 4; ++ks) wa[nt][ks] = ldg<bf16x8>(GUP, o + 64u * ks); } }
            const size_t mb = m0 + mt * 16; const int t = t0 + mt * 16 + tk;
            const bf16* zr = Z + mb * NINP + ZRW; const unsigned zo = (unsigned)(tk * NINP + h * 64 + 4 * g) * 2u + z0;
            bf16x8 bf[4];
#pragma unroll
            for (int ks = 0; ks < 4; ++ks) bf[ks] = *(const LAS bf16x8*)(act + (mt * 16 + tk) * ACT_LD + 32 * ks + 8 * g);
            if (MODE == 0) {
                float aq[4][4], nq[4][4], kqa[4][4]; float ssq = 0.f, bsum = 0.f;
#pragma unroll
                for (int nt = 0; nt < 4; ++nt) {
                    f32x4 cw = {0.f, 0.f, 0.f, 0.f}, ca = {0.f, 0.f, 0.f, 0.f};
                    cw = MFMA16(wa[nt][0], bf[0], cw); cw = MFMA16(wa[nt][1], bf[1], cw); ca = MFMA16(wa[nt][2], bf[2], ca); ca = MFMA16(wa[nt][3], bf[3], ca);
                    const unsigned co = choff + 64u * nt;
                    const f32x4 w0 = ldg<f32x4>(pw0, co), a0 = ldg<f32x4>(pa0, co), kkc = ldg<f32x4>(pkk, co), kac = ldg<f32x4>(pka, co), rkc = ldg<f32x4>(prk, co);
                    float zz[3][4];
#pragma unroll
                    for (int s = 0; s < 3; ++s) { const unsigned zc_o = zo + (unsigned)(512 * s + 16 * nt) * 2u; const v2u zc = ldg<v2u>(zr, zc_o); v2u zp = {0u, 0u}; if (t > 0) zp = ldg<v2u>(zr - NINP, zc_o);
                        const f32x4 mm = ldg<f32x4>(mu + 512 * s, co); const float x[4] = {bflo(zc.x), bfhi(zc.x), bflo(zc.y), bfhi(zc.y)}; const float p[4] = {bflo(zp.x), bfhi(zp.x), bflo(zp.y), bfhi(zp.y)};
#pragma unroll
                        for (int e = 0; e < 4; ++e) zz[s][e] = x[e] + mm[e] * (p[e] - x[e]); }
                    float dq[4], kq[4];
#pragma unroll
                    for (int e = 0; e < 4; ++e) { const float r = zz[0][e], k = zz[1][e];
                        const float ws_ = w0[e] + cw[e], a = sigmoidf_(a0[e] + ca[e]);
                        const float w_log = -softplusf_(-ws_) - 0.5f; dq[e] = __expf(-__expf(w_log));
                        const float kk = k * kkc[e]; ssq += kk * kk; nq[nt][e] = kk;
                        kq[e] = k * (1.0f + (a - 1.0f) * kac[e]); aq[nt][e] = a;
                        bsum += r * kq[e] * rkc[e]; }
                    const unsigned ro = (unsigned)(tk * 8 + h) * 1024u + z0;
                    stg<f32x4>(REC + mb * 8192, ro + (unsigned)(16 * nt + 4 * g) * 4u, (f32x4){dq[0], dq[1], dq[2], dq[3]});
                    stg<f32x4>(REC + mb * 8192, ro + 768u + (unsigned)(16 * nt + 4 * g) * 4u, (f32x4){zz[2][0], zz[2][1], zz[2][2], zz[2][3]});
                    v2u p0; p0.x = pkh2(zz[0][0], zz[0][1]); p0.y = pkh2(zz[0][2], zz[0][3]);
                    stg<v2u>(REC + mb * 8192, ro + 256u + (unsigned)(4 * nt + g) * 16u, p0);
#pragma unroll
                    for (int e = 0; e < 4; ++e) kqa[nt][e] = kq[e];

                }
                ssq = xsum4(ssq); bsum = xsum4(bsum);
                const float inr = 1.0f / fmaxf(sqrtf(ssq), 1e-12f);
                if (g == 0) stg<float>(BON + mb * 8 + h, (unsigned)tk * 32u, bsum);
#pragma unroll
                for (int nt = 0; nt < 4; ++nt) { float n4[4], b4[4];
#pragma unroll
                    for (int e = 0; e < 4; ++e) { n4[e] = nq[nt][e] * inr; b4[e] = n4[e] * aq[nt][e]; }
                    v2u p1; p1.x = pkh2(n4[0], n4[1]); p1.y = pkh2(n4[2], n4[3]);
                    stg<v2u>(REC + mb * 8192, (unsigned)(tk * 8 + h) * 1024u + z0 + 256u + (unsigned)(4 * nt + g) * 16u + 8u, p1);
                    v4u p2; p2.x = pkh2(kqa[nt][0], -b4[0]); p2.y = pkh2(kqa[nt][1], -b4[1]); p2.z = pkh2(kqa[nt][2], -b4[2]); p2.w = pkh2(kqa[nt][3], -b4[3]);
                    stg<v4u>(REC + mb * 8192, (unsigned)(tk * 8 + h) * 1024u + z0 + 512u + (unsigned)(4 * nt + g) * 16u, p2); }
            } else {
                float yq[4][4]; float ysum = 0.f;
                const unsigned yo = (unsigned)(tk * D + YRW + h * 64 + 4 * g) * 2u + z0;
#pragma unroll
                for (int nt = 0; nt < 4; ++nt) { const v2u yw = ldg<v2u>(Y + mb * D, yo + 32u * nt); yq[nt][0] = h2f_lo(yw.x); yq[nt][1] = h2f_hi(yw.x); yq[nt][2] = h2f_lo(yw.y); yq[nt][3] = h2f_hi(yw.y);
                    ysum += (yq[nt][0] + yq[nt][1]) + (yq[nt][2] + yq[nt][3]); }
                const float mean = xsum4(ysum) * (1.0f / 64.0f); float vs = 0.f;
#pragma unroll
                for (int nt = 0; nt < 4; ++nt)
#pragma unroll
                    for (int e = 0; e < 4; ++e) { const float d = yq[nt][e] - mean; vs += d * d; }
                const float rs = 1.0f / sqrtf(xsum4(vs) * (1.0f / 64.0f) + 64e-5f);
                const float bon = ldg<float>(BON + mb * 8 + h, (unsigned)tk * 32u);
#pragma unroll
                for (int nt = 0; nt < 4; ++nt) {
                    f32x4 cg = {0.f, 0.f, 0.f, 0.f};
#pragma unroll
                    for (int ks = 0; ks < 4; ++ks) cg = MFMA16(wa[nt][ks], bf[ks], cg);
                    const unsigned zc_o = zo + (unsigned)(1024 + 16 * nt) * 2u;
                    const v2u zc = ldg<v2u>(zr, zc_o); v2u zp = {0u, 0u}; if (t > 0) zp = ldg<v2u>(zr - NINP, zc_o);
                    const f32x4 mm = ldg<f32x4>(mu + 1024, choff + 64u * nt); const float x[4] = {bflo(zc.x), bfhi(zc.x), bflo(zc.y), bfhi(zc.y)}; const float p[4] = {bflo(zp.x), bfhi(zp.x), bflo(zp.y), bfhi(zp.y)};
                    const f32x4 l0 = ldg<f32x4>(pln, choff + 64u * nt), l1 = ldg<f32x4>(pln + 512, choff + 64u * nt);
                    float o[4];
#pragma unroll
                    for (int e = 0; e < 4; ++e) { const float v = x[e] + mm[e] * (p[e] - x[e]); o[e] = ((yq[nt][e] - mean) * rs * l0[e] + l1[e] + bon * v) * cg[e]; }
                    v2u w; w.x = pk2(o[0], o[1]); w.y = pk2(o[2], o[3]); stg<v2u>(Y + mb * D, yo + 32u * nt, w);
                     }
            }
        }
        __syncthreads();
    }
}

template <int CTRL> __device__ __forceinline__ float dpp_add(float v) { return v + dpp_mov<CTRL>(v); }
__device__ __forceinline__ float row16_sum(float v) { v = dpp_add<0xB1>(v); v = dpp_add<0x4E>(v); v = dpp_add<0x141>(v); return dpp_add<0x140>(v); }
typedef _Float16 h2v __attribute__((ext_vector_type(2)));
__device__ __forceinline__ float dot2z(unsigned a, h2v b) { float r; asm("v_dot2_f32_f16 %0, %1, %2, 0" : "=v"(r) : "v"(a), "v"(b)); return r; }
__device__ __forceinline__ float fmix_lo(unsigned h, float b, float c) { return __builtin_fmaf((float)__builtin_bit_cast(h2v, h).x, b, c); }
__device__ __forceinline__ float fmix_hi(unsigned h, float b, float c) { return __builtin_fmaf((float)__builtin_bit_cast(h2v, h).y, b, c); }
__device__ __forceinline__ unsigned pkh2(float a, float b) { const _Float16 ha = (_Float16)a, hb = (_Float16)b; return (unsigned)__builtin_bit_cast(unsigned short, ha) | ((unsigned)__builtin_bit_cast(unsigned short, hb) << 16); }
__device__ __forceinline__ float fmix2_lo(unsigned hk, unsigned hv, float c) { return __builtin_fmaf((float)__builtin_bit_cast(h2v, hk).x, (float)__builtin_bit_cast(h2v, hv).x, c); }
__device__ __forceinline__ float fmix2_hi(unsigned hk, unsigned hv, float c) { return __builtin_fmaf((float)__builtin_bit_cast(h2v, hk).y, (float)__builtin_bit_cast(h2v, hv).x, c); }
__device__ __forceinline__ void rwkv_scan_v2(Frame& F, int grp) {
    const int lane = lane_id_fresh(), c = lane & 15, rho = lane >> 4;
    const int bh = grp >> 4, b = bh >> 3, h = bh & 7, i = (grp & 15) * 4 + rho;
    const GAS unsigned char* recn = (const GAS unsigned char*)(F.ws + WS_MIX + ((size_t)(b * T) * 8 + h) * 1024) + lane * 16;
    GAS unsigned char* ys = (GAS unsigned char*)((bf16*)(F.ws + WS_H) + ((size_t)(b * T) + (lane & 31)) * D + YRW + h * 64 + (grp & 15) * 4 + 2 * (lane >> 5)) - (size_t)2 * D;
    LAS unsigned char* yst = F.lds + SCAN_YSTAGE_OFF;
    LAS unsigned char* ring = F.lds + SCAN_RING_OFF;
    constexpr int R = SCAN_R;
    static_assert(R <= 32 && T % R == 0, "ring depth");
#define SCAN_DMA(slot) do { __builtin_amdgcn_global_load_lds((const GAS unsigned*)recn, (LAS unsigned*)(ring + (slot) * 1024), 16, 0, 0); recn += 8192; asm volatile("" : "+v"(recn)); } while (0)
#pragma unroll
    for (int s = 0; s < R; ++s) SCAN_DMA(s);
    asm volatile("s_waitcnt vmcnt(0)" ::: "memory");
    const LAS unsigned char* aw = ring + 16 * c; const LAS unsigned char* ap = ring + 256 + 16 * c; const LAS unsigned char* av = ring + 768 + 4 * i;
    float S0 = 0.f, S1 = 0.f, S2 = 0.f, S3 = 0.f;
    f32x4 W[4]; v4u A[4], B[4]; unsigned V[4];
    const unsigned aw_ = (unsigned)(size_t)aw, apx_ = (unsigned)(size_t)ap, av_ = (unsigned)(size_t)av;
#define SCAN_LDS(buf, slot) do { \
        asm volatile("ds_read_b128 %0, %1 offset:%2" : "=v"(W[buf]) : "v"(aw_), "n"((slot) * 1024)); \
        asm volatile("ds_read_b128 %0, %1 offset:%2" : "=v"(A[buf]) : "v"(apx_), "n"((slot) * 1024)); \
        asm volatile("ds_read_b128 %0, %1 offset:%2" : "=v"(B[buf]) : "v"(apx_), "n"((slot) * 1024 + 256)); \
        asm volatile("ds_read_b32 %0, %1 offset:%2" : "=v"(V[buf]) : "v"(av_), "n"((slot) * 1024)); } while (0)
#define SCAN_SEE(buf, cnt) asm volatile("s_waitcnt lgkmcnt(%4)" : "+v"(W[buf]), "+v"(A[buf]), "+v"(B[buf]), "+v"(V[buf]) : "n"(cnt))
    W[2] = W[3] = (f32x4){0.f, 0.f, 0.f, 0.f}; A[2] = A[3] = B[2] = B[3] = (v4u){0u, 0u, 0u, 0u}; V[2] = V[3] = 0u;
    __builtin_amdgcn_s_setprio(3);
    for (int tb = 0; tb < T; tb += R) {
        SCAN_LDS(0, 0); SCAN_LDS(1, 1);
        SCAN_SEE(0, 0); SCAN_SEE(1, 0); SCAN_SEE(2, 0); SCAN_SEE(3, 0);
#pragma unroll
        for (int u = 0; u < R; ++u) {
            const int cu = u & 3, nu = (u + 2) & 3;
            if (u + 2 < R) { asm volatile("s_waitcnt vmcnt(%0)" :: "n"(R - 3) : "memory");
                SCAN_LDS(nu, u + 2); }
            if (u + 2 < R) SCAN_SEE(cu, 8); else if (u + 2 == R) SCAN_SEE(cu, 4); else SCAN_SEE(cu, 0);
            const f32x4 w = W[cu]; const v4u a = A[cu], kb = B[cu]; const float vf = __uint_as_float(V[cu]);
            const v4u ap_ = A[(u + 3) & 3];
            const h2v s01 = __builtin_bit_cast(h2v, __builtin_amdgcn_cvt_pkrtz(S0, S1)), s23 = __builtin_bit_cast(h2v, __builtin_amdgcn_cvt_pkrtz(S2, S3));
            const unsigned n01 = a.z, n23 = a.w, r01 = ap_.x, r23 = ap_.y;
            float p = __builtin_amdgcn_fdot2(__builtin_bit_cast(h2v, n23), s23, dot2z(n01, s01), false);
            float y = __builtin_amdgcn_fdot2(__builtin_bit_cast(h2v, r23), s23, dot2z(r01, s01), false);
            p = row16_sum(p);
            y = row16_sum(y);
            { const h2v vp = __builtin_bit_cast(h2v, __builtin_amdgcn_cvt_pkrtz(vf, p));
              const unsigned k0 = kb.x, k1 = kb.y, k2 = kb.z, k3 = kb.w;
              const v2f sw01 = (v2f){S0, S1} * (v2f){w.x, w.y}, sw23 = (v2f){S2, S3} * (v2f){w.z, w.w};
              S0 = __builtin_amdgcn_fdot2(__builtin_bit_cast(h2v, k0), vp, sw01.x, false); S1 = __builtin_amdgcn_fdot2(__builtin_bit_cast(h2v, k1), vp, sw01.y, false);
              S2 = __builtin_amdgcn_fdot2(__builtin_bit_cast(h2v, k2), vp, sw23.x, false); S3 = __builtin_amdgcn_fdot2(__builtin_bit_cast(h2v, k3), vp, sw23.y, false); }
            *(LAS float*)(yst + rho * 4 + u * 16) = y;
            if (u + 2 >= R) asm volatile("" ::: "memory");
            SCAN_DMA(u);
        }
        asm volatile("s_waitcnt vmcnt(%0)" :: "n"(R - 2) : "memory");
        { const v2f yy = *(const LAS v2f*)(yst + (lane & 31) * 16 + (lane >> 5) * 8); if (tb > 0 || (lane & 31) > 0) *(GAS unsigned*)ys = pkh2(yy.x, yy.y); ys += (size_t)R * 2 * D; asm volatile("" : "+v"(ys)); }
    }
    {
        const v4u al = A[3];
        const unsigned r01 = al.x, r23 = al.y;
        const h2v s01 = __builtin_bit_cast(h2v, __builtin_amdgcn_cvt_pkrtz(S0, S1)), s23 = __builtin_bit_cast(h2v, __builtin_amdgcn_cvt_pkrtz(S2, S3));
        float y = __builtin_amdgcn_fdot2(__builtin_bit_cast(h2v, r23), s23, __builtin_amdgcn_fdot2(__builtin_bit_cast(h2v, r01), s01, 0.f, false), false);
        y = row16_sum(y);
        *(GAS _Float16*)((bf16*)(F.ws + WS_H) + ((size_t)(b * T) + T - 1) * D + YRW + h * 64 + i) = (_Float16)y;
    }
#undef SCAN_LDS
#undef SCAN_SEE
    __builtin_amdgcn_s_setprio(0);
    asm volatile("s_waitcnt vmcnt(0)" ::: "memory");
#undef SCAN_DMA
}

constexpr int VT_LD = 72;
__device__ __forceinline__ void ph_mlA(Frame& F, int l) {
    const bf16* Z = (const bf16*)(F.ws + WS_ZA);
    bf16* MQ = (bf16*)(F.ws + WS_MIX + MX_MQ); bf16* MK = (bf16*)(F.ws + WS_MIX + MX_MK);
    float* LF = (float*)(F.ws + WS_MLF); float* LI = (float*)(F.ws + WS_MLI);
    float* G_ = (float*)(F.ws + WS_MLG); float* A_ = G_ + 2048;
    float* U = (float*)(F.ws + WS_MIX + MX_U); float* NP = (float*)(F.ws + WS_MLNP);
    LAS unsigned short* vT = (LAS unsigned short*)F.lds;
    LAS unsigned short* kT = vT + 128 * VT_LD;
    LAS float* wv = (LAS float*)(kT + 128 * VT_LD);
    LAS float* lfs = wv + 64;
    LAS float* cwl = lfs + 64;
    const float* cw = F.inp(15) + (size_t)l * 4 * 1024; const float* cb = F.inp(16) + (size_t)l * 1024; const float* gb = F.inp(17) + (size_t)l * 8;
    const int lane = F.lane, tk = lane & 15, g = lane >> 4;
    for (int it = F.bid; it < 2048; it += F.G) {
        const int bh = it >> 8, ck = it & 255, b = bh >> 2, h = bh & 3; const size_t m0 = (size_t)b * T + ck * 64; const int t0 = ck * 64;
        const unsigned z0 = (unsigned)opq(0);
        const bf16* zb = Z + m0 * NINP;
        if (F.wave == 0) {
            const float f = bf2f(ldg<unsigned short>(zb, (unsigned)(lane * NINP + ZMF + h) * 2u + z0)) + gb[4 + h];
            const float ii = bf2f(ldg<unsigned short>(zb, (unsigned)(lane * NINP + ZMI + h) * 2u + z0)) + gb[h];
            const float lf = logsigmoidf_(f);
            lfs[lane] = lf;
            const float cum = wave_prefix_sum(lf, lane);
            const float gtot = rdlane(cum, 63);
            const float lw = gtot - cum + ii; const float a = wave_max(lw);
            wv[lane] = __expf(lw - a);
            LF[(size_t)bh * T + t0 + lane] = lf; LI[(size_t)bh * T + t0 + lane] = ii;
            if (lane == 0) { G_[it] = gtot; A_[it] = a; }
        }
        for (int i = F.tid; i < 5 * 256; i += NTHREADS) { const int j = i >> 8, c = i & 255; const int ch = (c < 128) ? (h * 128 + c) : (512 + h * 128 + c - 128); cwl[i] = (j < 4) ? cw[j * 1024 + ch] : cb[ch]; }
        __syncthreads();
        for (int idx = F.tid; idx < 64 * 32; idx += NTHREADS) {
            const int s = idx >> 5, c8 = (idx & 31) * 8; const int zcol = (c8 < 128) ? (ZMQ + h * 128 + c8) : (ZMK + h * 128 + c8 - 128);
            float acc[8];
#pragma unroll
            for (int e = 0; e < 8; ++e) acc[e] = cwl[4 * 256 + c8 + e];
#pragma unroll
            for (int j = 0; j < 4; ++j) { const int tt = t0 + s - 3 + j;
                if (tt >= 0) { const v4u w = ldg<v4u>(zb - 3 * NINP, (unsigned)((s + j) * NINP + zcol) * 2u + z0); const float x[8] = {bflo(w.x), bfhi(w.x), bflo(w.y), bfhi(w.y), bflo(w.z), bfhi(w.z), bflo(w.w), bfhi(w.w)};
#pragma unroll
                    for (int e = 0; e < 8; ++e) acc[e] += cwl[j * 256 + c8 + e] * x[e]; } }
            unsigned short o[8];
            if (c8 < 128) {
#pragma unroll
                for (int e = 0; e < 8; ++e) o[e] = (unsigned short)f2bf(siluf_(acc[e]));
                v4u w; w.x = o[0] | ((unsigned)o[1] << 16); w.y = o[2] | ((unsigned)o[3] << 16); w.z = o[4] | ((unsigned)o[5] << 16); w.w = o[6] | ((unsigned)o[7] << 16);
                stg<v4u>(MQ + m0 * 512, (unsigned)(s * 512 + h * 128 + c8) * 2u + z0, w);
            } else {
                const float ws_ = wv[s];
#pragma unroll
                for (int e = 0; e < 8; ++e) { const float kv = siluf_(acc[e]) * 0.08838834764831845f; o[e] = (unsigned short)f2bf(kv); kT[(c8 - 128 + e) * VT_LD + s] = (unsigned short)f2bf(bf2f(o[e]) * ws_); }
                v4u w; w.x = o[0] | ((unsigned)o[1] << 16); w.y = o[2] | ((unsigned)o[3] << 16); w.z = o[4] | ((unsigned)o[5] << 16); w.w = o[6] | ((unsigned)o[7] << 16);
                stg<v4u>(MK + m0 * 512, (unsigned)(s * 512 + h * 128 + c8 - 128) * 2u + z0, w);
            }
        }
        for (int idx = F.tid; idx < 64 * 16; idx += NTHREADS) {
            const int s = idx >> 4, c8 = (idx & 15) * 8; const v4u w = ldg<v4u>(zb, (unsigned)(s * NINP + ZMV + h * 128 + c8) * 2u + z0);
            const unsigned short x[8] = {(unsigned short)w.x, (unsigned short)(w.x >> 16), (unsigned short)w.y, (unsigned short)(w.y >> 16), (unsigned short)w.z, (unsigned short)(w.z >> 16), (unsigned short)w.w, (unsigned short)(w.w >> 16)};
#pragma unroll
            for (int e = 0; e < 8; ++e) vT[(c8 + e) * VT_LD + s] = x[e]; }
        __syncthreads();
        {
            bf16x8 af[2];
#pragma unroll
            for (int ks = 0; ks < 2; ++ks) af[ks] = *(const LAS bf16x8*)(vT + (F.wave * 16 + tk) * VT_LD + 32 * ks + 8 * g);
            float* ub = U + (size_t)it * 16384;
#pragma unroll
            for (int j = 0; j < 8; ++j) { f32x4 acc = {0.f, 0.f, 0.f, 0.f};
#pragma unroll
                for (int ks = 0; ks < 2; ++ks) { const bf16x8 bfr = *(const LAS bf16x8*)(kT + (j * 16 + tk) * VT_LD + 32 * ks + 8 * g); acc = MFMA16(af[ks], bfr, acc); }
#pragma unroll
                for (int r = 0; r < 4; ++r) stg<float>(ub, (unsigned)((F.wave * 16 + 4 * g + r) * 128 + j * 16 + tk) * 4u + z0, acc[r]); }
            if (F.tid < 128) { float s = 0.f; for (int q = 0; q < 64; ++q) s += bf2f(kT[F.tid * VT_LD + q]); NP[(size_t)it * 128 + F.tid] = s; }
        }
        __syncthreads();
    }
}
__device__ __forceinline__ void ph_mlB(Frame& F) {
    const float* __restrict__ G_ = (const float*)(F.ws + WS_MLG); const float* __restrict__ A_ = G_ + 2048; float* __restrict__ M_ = (float*)(F.ws + WS_MLG) + 4096;
    const float* __restrict__ U = (const float*)(F.ws + WS_MIX + MX_U); bf16* __restrict__ CT = (bf16*)(F.ws + WS_MIX + MX_CT);
    const float* __restrict__ NP = (const float*)(F.ws + WS_MLNP); float* __restrict__ NS = (float*)(F.ws + WS_MLNS);
    for (int gid = F.bid * NTHREADS + F.tid; gid < 8 * 16384; gid += F.G * NTHREADS) {
        const int bh = gid >> 14, e = gid & 16383;
        float C = 0.f, n = 0.f, m = 0.f;
        for (int k0 = 0; k0 < 256; k0 += 8) {
            float u[8], np[8], gg[8], aa[8];
#pragma unroll
            for (int q = 0; q < 8; ++q) { const int it = bh * 256 + k0 + q; u[q] = U[(size_t)it * 16384 + e]; gg[q] = G_[it]; aa[q] = A_[it]; np[q] = (e < 128) ? NP[(size_t)it * 128 + e] : 0.f; }
#pragma unroll
            for (int q = 0; q < 8; ++q) { const int it = bh * 256 + k0 + q;
                CT[(size_t)it * 16384 + e] = (bf16)f2bf(C);
                if (e < 128) NS[(size_t)it * 128 + e] = n;
                if (e == 0) M_[it] = m;
                const float mn = fmaxf(gg[q] + m, aa[q]); const float dec = __expf(gg[q] + m - mn), ee = __expf(aa[q] - mn);
                C = dec * C + ee * u[q]; n = dec * n + ee * np[q]; m = mn; }
        }
    }
}
__device__ __forceinline__ void ph_mlC(Frame& F, int l) {
    const bf16* Z = (const bf16*)(F.ws + WS_ZA);
    const bf16* MQ = (const bf16*)(F.ws + WS_MIX + MX_MQ); const bf16* MK = (const bf16*)(F.ws + WS_MIX + MX_MK);
    const float* LF = (const float*)(F.ws + WS_MLF); const float* LI = (const float*)(F.ws + WS_MLI);
    const float* M_ = (const float*)(F.ws + WS_MLG) + 4096; const bf16* CT = (const bf16*)(F.ws + WS_MIX + MX_CT); const float* NS = (const float*)(F.ws + WS_MLNS);
    const float* gn = F.inp(18) + (size_t)l * 512;
    bf16* Y = (bf16*)(F.ws + WS_H);
    LAS unsigned short* vT = (LAS unsigned short*)F.lds;
    LAS float* bc = (LAS float*)(vT + 128 * VT_LD);
    LAS float* cs = bc + 64;
    LAS float* pm = cs + 64;
    LAS float* nv = pm + 64;
    LAS float* st = nv + 128;
    const int lane = F.lane, tk = lane & 15, g = lane >> 4, tt = F.wave & 3, dh = F.wave >> 2;
    for (int it = F.bid; it < 2048; it += F.G) {
        const int bh = it >> 8, ck = it & 255, b = bh >> 2, h = bh & 3; const size_t m0 = (size_t)b * T + ck * 64; const int t0 = ck * 64;
        const unsigned z0 = (unsigned)opq(0);
        const bf16* zb = Z + m0 * NINP;
        const float mprev = M_[it];
        if (F.wave == 0) {
            const float lf = LF[(size_t)bh * T + t0 + lane], ii = LI[(size_t)bh * T + t0 + lane];
            const float cum = wave_prefix_sum(lf, lane);
            const float c = ii - cum; cs[lane] = c;
            const float mx = wave_prefix_max(c, lane);
            pm[lane] = mx; bc[lane] = cum;
        } else if (F.wave == 1) { nv[lane] = NS[(size_t)it * 128 + lane]; nv[64 + lane] = NS[(size_t)it * 128 + 64 + lane]; }
        for (int idx = F.tid; idx < 64 * 16; idx += NTHREADS) {
            const int s = idx >> 4, c8 = (idx & 15) * 8; const v4u w = ldg<v4u>(zb, (unsigned)(s * NINP + ZMV + h * 128 + c8) * 2u + z0);
            const unsigned short x[8] = {(unsigned short)w.x, (unsigned short)(w.x >> 16), (unsigned short)w.y, (unsigned short)(w.y >> 16), (unsigned short)w.z, (unsigned short)(w.z >> 16), (unsigned short)w.w, (unsigned short)(w.w >> 16)};
#pragma unroll
            for (int e = 0; e < 8; ++e) vT[(c8 + e) * VT_LD + s] = x[e]; }
        __syncthreads();
        const int t = tt * 16 + tk;
        bf16x8 qf[4];
#pragma unroll
        for (int ks = 0; ks < 4; ++ks) qf[ks] = ldg<bf16x8>(MQ + m0 * 512, (unsigned)(t * 512 + h * 128 + 32 * ks + 8 * g) * 2u + z0);
        const float bt = bc[t], mt = bt + fmaxf(pm[t], mprev), wt = __expf(bt + mprev - mt);
        f32x4 P[4]; float dsum = 0.f;
#pragma unroll
        for (int sti = 0; sti < 4; ++sti) {
            P[sti] = (f32x4){0.f, 0.f, 0.f, 0.f};
            if (sti <= tt) {
                f32x4 S = {0.f, 0.f, 0.f, 0.f};
#pragma unroll
                for (int ks = 0; ks < 4; ++ks) { const bf16x8 kf = ldg<bf16x8>(MK + m0 * 512, (unsigned)((sti * 16 + tk) * 512 + h * 128 + 32 * ks + 8 * g) * 2u + z0); S = MFMA16(kf, qf[ks], S); }
                const f32x4 c4 = *(const LAS f32x4*)(cs + sti * 16 + 4 * g);
#pragma unroll
                for (int r = 0; r < 4; ++r) { const int s = sti * 16 + 4 * g + r; const float p = (s <= t) ? S[r] * __expf(bt + c4[r] - mt) : 0.f; P[sti][r] = p; dsum += p; }
            }
        }
        float qn = 0.f;
#pragma unroll
        for (int ks = 0; ks < 4; ++ks) { const v4u w = __builtin_bit_cast(v4u, qf[ks]); const f32x4 n0 = *(const LAS f32x4*)(nv + 32 * ks + 8 * g), n1 = *(const LAS f32x4*)(nv + 32 * ks + 8 * g + 4);
            qn += bflo(w.x) * n0[0] + bfhi(w.x) * n0[1] + bflo(w.y) * n0[2] + bfhi(w.y) * n0[3] + bflo(w.z) * n1[0] + bfhi(w.z) * n1[1] + bflo(w.w) * n1[2] + bfhi(w.w) * n1[3]; }
        const float den = xsum4(dsum) + wt * xsum4(qn);
        const float rden = 1.0f / fmaxf(fabsf(den), __expf(-mt));
        bf16x8 pf[2];
#pragma unroll
        for (int kk = 0; kk < 2; ++kk) { const v4u w = {cvtpk(P[2 * kk][0], P[2 * kk][1]), cvtpk(P[2 * kk][2], P[2 * kk][3]), cvtpk(P[2 * kk + 1][0], P[2 * kk + 1][1]), cvtpk(P[2 * kk + 1][2], P[2 * kk + 1][3])}; pf[kk] = __builtin_bit_cast(bf16x8, w); }
        float hv[4][4]; float s1 = 0.f, s2 = 0.f;
#pragma unroll
        for (int dvt = 0; dvt < 4; ++dvt) {
            const int dvr = dh * 64 + dvt * 16 + tk;
            f32x4 a1 = {0.f, 0.f, 0.f, 0.f}, a2 = {0.f, 0.f, 0.f, 0.f};
#pragma unroll
            for (int kk = 0; kk < 2; ++kk) { const v2u lo = *(const LAS v2u*)(vT + dvr * VT_LD + 32 * kk + 4 * g), hi = *(const LAS v2u*)(vT + dvr * VT_LD + 32 * kk + 16 + 4 * g);
                const v4u w = {lo.x, lo.y, hi.x, hi.y}; a1 = MFMA16(__builtin_bit_cast(bf16x8, w), pf[kk], a1); }
#pragma unroll
            for (int ks = 0; ks < 4; ++ks) { const bf16x8 cf = ldg<bf16x8>(CT + (size_t)it * 16384, (unsigned)(dvr * 128 + 32 * ks + 8 * g) * 2u + z0); a2 = MFMA16(cf, qf[ks], a2); }
            const v2u ow = ldg<v2u>(zb, (unsigned)(t * NINP + ZMO + h * 128 + dh * 64 + dvt * 16 + 4 * g) * 2u + z0);
            const float og[4] = {bflo(ow.x), bfhi(ow.x), bflo(ow.y), bfhi(ow.y)};
#pragma unroll
            for (int r = 0; r < 4; ++r) { const float x = sigmoidf_(og[r]) * ((a1[r] + wt * a2[r]) * rden); hv[dvt][r] = x; s1 += x; s2 += x * x; }
        }
        s1 = xsum4(s1); s2 = xsum4(s2);
        if (g == 0) { st[(dh * 64 + t) * 2] = s1; st[(dh * 64 + t) * 2 + 1] = s2; }
        __syncthreads();
        { const float o1 = st[((dh ^ 1) * 64 + t) * 2], o2 = st[((dh ^ 1) * 64 + t) * 2 + 1];
          const float mean = (s1 + o1) * (1.0f / 128.0f); const float var = fmaxf((s2 + o2) * (1.0f / 128.0f) - mean * mean, 0.f); const float rs = 1.0f / sqrtf(var + 1e-6f);
#pragma unroll
          for (int dvt = 0; dvt < 4; ++dvt) { const int dv = dh * 64 + dvt * 16 + 4 * g; const f32x4 gg = ldg<f32x4>(gn, (unsigned)(h * 128 + dv) * 4u + z0);
              float o[4];
#pragma unroll
              for (int r = 0; r < 4; ++r) o[r] = (hv[dvt][r] - mean) * rs * gg[r];
              v2u w; w.x = pk2(o[0], o[1]); w.y = pk2(o[2], o[3]); stg<v2u>(Y + m0 * D, (unsigned)(t * D + YML + h * 128 + dv) * 2u + z0, w); } }
        __syncthreads();
    }
}

constexpr float LOG2E = 1.4426950408889634f;
constexpr float QSCALE2 = 0.125f * 1.4426950408889634f;
constexpr size_t WS_VCT = 3 * MiB;
constexpr size_t WS_VTS = 1142 * MiB, WS_VTW = 1158 * MiB;
constexpr size_t WS_END2 = 1174 * MiB;
constexpr int CW_NSAQ = 8192;


typedef __amdgpu_buffer_rsrc_t brsrc;
__device__ __forceinline__ brsrc mk_rsrc(const void* p) { return __builtin_amdgcn_make_buffer_rsrc((void*)p, 0, 0x7fffffff, 0x00020000); }
struct LdOff { int q, g, kstride, vstride; };
__device__ __forceinline__ void nsa_ldk(bf16x8 (&k)[2][2], brsrc rs, int soff, const LdOff& lo) {
    const int o0 = opq(lo.q * lo.kstride + lo.g * 16); const int off[2] = {o0, o0 + 16 * lo.kstride};
#pragma unroll
    for (int t = 0; t < 2; ++t) { k[t][0] = __builtin_bit_cast(bf16x8, __builtin_amdgcn_raw_buffer_load_b128(rs, (int)off[t], soff, 0)); k[t][1] = __builtin_bit_cast(bf16x8, __builtin_amdgcn_raw_buffer_load_b128(rs, (int)off[t], soff + 64, 0)); }
}
__device__ __forceinline__ void nsa_ldv(bf16x8 (&v)[4], brsrc rs, int soff, const LdOff& lo) {
    const int o0 = opq(lo.q * lo.vstride + lo.g * 8); const int off[4] = {o0, o0 + 16 * lo.vstride, o0 + 32 * lo.vstride, o0 + 48 * lo.vstride};
#pragma unroll
    for (int dt = 0; dt < 4; ++dt) { const v2u lo = __builtin_bit_cast(v2u, __builtin_amdgcn_raw_buffer_load_b64(rs, (int)off[dt], soff, 0)), hi = __builtin_bit_cast(v2u, __builtin_amdgcn_raw_buffer_load_b64(rs, (int)off[dt], soff + 32, 0));
        const v4u w = {lo.x, lo.y, hi.x, hi.y}; v[dt] = __builtin_bit_cast(bf16x8, w); }
}
__device__ __forceinline__ void nsa_qk2(f32x4 (&S)[2][2], const bf16x8 (&kf)[2][2], const bf16x8 (&qf)[4][2], const int hp) {
#pragma unroll
    for (int t = 0; t < 2; ++t)
#pragma unroll
        for (int j = 0; j < 2; ++j) { f32x4 a = {0.f, 0.f, 0.f, 0.f}; a = MFMA16(kf[t][0], qf[2 * hp + j][0], a); S[t][j] = MFMA16(kf[t][1], qf[2 * hp + j][1], a); }
}
template <class EF> __device__ __forceinline__ void nsa_scores_near2(f32x4 (&S)[2][2], const EF& ef, const LAS f32x4* lut, float (&mx)[2], const int hp) {
    mx[0] = -INFINITY; mx[1] = -INFINITY;
#pragma unroll
    for (int t = 0; t < 2; ++t) { f32x4 bb[4]; bool ok[4];
#pragma unroll
        for (int r = 0; r < 4; ++r) { int li; ok[r] = ef(t, r, li); bb[r] = lut[li]; }
#pragma unroll
        for (int r = 0; r < 4; ++r)
#pragma unroll
            for (int j = 0; j < 2; ++j) { const float s = ok[r] ? fmaf(S[t][j][r], QSCALE2, bb[r][2 * hp + j]) : -INFINITY; S[t][j][r] = s; mx[j] = fmaxf(mx[j], s); } }
}
__device__ __forceinline__ float max8(const f32x4& a, const f32x4& b) { return fmaxf(fmaxf(fmaxf(a[0], a[1]), fmaxf(a[2], a[3])), fmaxf(fmaxf(b[0], b[1]), fmaxf(b[2], b[3]))); }
__device__ __forceinline__ void nsa_pv2(f32x4 (&O)[4][4], const f32x4 (&P)[2][2], const bf16x8 (&vf)[4], const int hp) {
#pragma unroll
    for (int j = 0; j < 2; ++j) { const v4u w = {cvtpk(P[0][j][0], P[0][j][1]), cvtpk(P[0][j][2], P[0][j][3]), cvtpk(P[1][j][0], P[1][j][1]), cvtpk(P[1][j][2], P[1][j][3])};
        const bf16x8 pf = __builtin_bit_cast(bf16x8, w);
#pragma unroll
        for (int dt = 0; dt < 4; ++dt) O[2 * hp + j][dt] = MFMA16(vf[dt], pf, O[2 * hp + j][dt]); }
}
template <bool FAR, class EF> __device__ __forceinline__ void nsa_step_online(bf16x8 (&kf)[2][2], bf16x8 (&vf)[4], const LAS bf16x8* qlds  , const EF& ef, const LAS f32x4* lut, bool on,
                                                                   float (&m)[4], float (&l)[4], f32x4 (&O)[4][4], brsrc krs, int ksoff, brsrc vrs, int vsoff, const LdOff& lo) {
#pragma unroll
    for (int hp = 0; hp < 2; ++hp) {
        f32x4 S[2][2]; float mx[2];
        bf16x8 qp[2][2];
#pragma unroll
        for (int j = 0; j < 2; ++j) { qp[j][0] = qlds[((2 * hp + j) * 2 + 0) * 64]; qp[j][1] = qlds[((2 * hp + j) * 2 + 1) * 64]; }
#pragma unroll
        for (int t = 0; t < 2; ++t)
#pragma unroll
            for (int j = 0; j < 2; ++j) { f32x4 a = {0.f, 0.f, 0.f, 0.f}; a = MFMA16(kf[t][0], qp[j][0], a); S[t][j] = MFMA16(kf[t][1], qp[j][1], a); }
        if (hp == 1) nsa_ldk(kf, krs, ksoff, lo);
        f32x4 bfar; if (FAR) bfar = lut[127];
        if (FAR) {
#pragma unroll
            for (int j = 0; j < 2; ++j) mx[j] = on ? fmaf(max8(S[0][j], S[1][j]), QSCALE2, bfar[2 * hp + j]) : -INFINITY;
        } else nsa_scores_near2(S, ef, lut, mx, hp);
        float alpha[2]; bool chg = false;
#pragma unroll
        for (int j = 0; j < 2; ++j) { const int h = 2 * hp + j; const float mall = xmax4(mx[j]); const float mn = fmaxf(m[h], mall); const float mref = (mn == -INFINITY) ? 0.f : mn;
            alpha[j] = __builtin_amdgcn_exp2f(m[h] - mref); chg = chg || (mn > m[h]); m[h] = mn;
            float ps = 0.f;
            if (FAR) { const float bm = on ? (bfar[h] - mref) : -INFINITY;
#pragma unroll
                for (int t = 0; t < 2; ++t)
#pragma unroll
                    for (int r = 0; r < 4; ++r) { const float p = __builtin_amdgcn_exp2f(fmaf(S[t][j][r], QSCALE2, bm)); S[t][j][r] = p; ps += p; }
            } else {
#pragma unroll
                for (int t = 0; t < 2; ++t)
#pragma unroll
                    for (int r = 0; r < 4; ++r) { const float p = __builtin_amdgcn_exp2f(S[t][j][r] - mref); S[t][j][r] = p; ps += p; } }
            l[h] = l[h] * alpha[j] + ps; }
        if (__builtin_amdgcn_ballot_w64(chg) != 0ull) {
#pragma unroll
            for (int j = 0; j < 2; ++j)
#pragma unroll
                for (int dt = 0; dt < 4; ++dt) O[2 * hp + j][dt] *= alpha[j]; }
        nsa_pv2(O, S, vf, hp);
        __builtin_amdgcn_sched_barrier(0);
    }
    nsa_ldv(vf, vrs, vsoff, lo);
}


#define MFMA8(a, b, c) __builtin_amdgcn_mfma_f32_16x16x32_fp8_fp8((a), (b), (c), 0, 0, 0)
__device__ __forceinline__ unsigned pk_fp8x4(float a, float b, float c, float d) { int w = __builtin_amdgcn_cvt_pk_fp8_f32(a, b, 0, false); w = __builtin_amdgcn_cvt_pk_fp8_f32(c, d, w, true); return (unsigned)w; }
__device__ __forceinline__ long mk64(unsigned a, unsigned b) { const v2u w = {a, b}; return __builtin_bit_cast(long, w); }
__device__ __forceinline__ void nsa_ldk8(v4u (&k)[2], brsrc rs, int soff, int ko) {
    const int o = opq(ko);
    k[0] = __builtin_bit_cast(v4u, __builtin_amdgcn_raw_buffer_load_b128(rs, o, soff, 0)); k[1] = __builtin_bit_cast(v4u, __builtin_amdgcn_raw_buffer_load_b128(rs, o, soff + 1024, 0));
}
__device__ __forceinline__ void nsa_ldv8(v2u (&v)[4], brsrc rs, int soff, int vo) {
    const int o = opq(vo);
#pragma unroll
    for (int dt = 0; dt < 4; ++dt) v[dt] = __builtin_bit_cast(v2u, __builtin_amdgcn_raw_buffer_load_b64(rs, o, soff + dt * 1024, 0));
}
template <bool FAR, class EF> __device__ __forceinline__ void nsa_step_online8(v4u (&kr)[2], v2u (&vr)[4], const LAS v4u* qlds  , const EF& ef, const LAS f32x4* lut, bool on,
                                                                   float (&m)[4], float (&l)[4], f32x4 (&O)[4][4], brsrc krs, int ksoff, brsrc vrs, int vsoff, int ko, int vo) {
#pragma unroll
    for (int hp = 0; hp < 2; ++hp) {
        f32x4 S[2][2]; float mx[2];
        v4u qp[2];
#pragma unroll
        for (int j = 0; j < 2; ++j) qp[j] = qlds[(2 * hp + j) * 64];
#pragma unroll
        for (int t = 0; t < 2; ++t)
#pragma unroll
            for (int j = 0; j < 2; ++j) { f32x4 a = {0.f, 0.f, 0.f, 0.f}; a = MFMA8(mk64(kr[t].x, kr[t].y), mk64(qp[j].x, qp[j].y), a); S[t][j] = MFMA8(mk64(kr[t].z, kr[t].w), mk64(qp[j].z, qp[j].w), a); }
        if (hp == 1) nsa_ldk8(kr, krs, ksoff, ko);
        f32x4 bfar; if (FAR) bfar = lut[127];
        if (FAR) {
#pragma unroll
            for (int j = 0; j < 2; ++j) mx[j] = on ? fmaf(max8(S[0][j], S[1][j]), QSCALE2, bfar[2 * hp + j]) : -INFINITY;
        } else nsa_scores_near2(S, ef, lut, mx, hp);
        float alpha[2]; bool chg = false;
#pragma unroll
        for (int j = 0; j < 2; ++j) { const int h = 2 * hp + j; const float mall = xmax4(mx[j]); const float mn = fmaxf(m[h], mall); const float mref = (mn == -INFINITY) ? 0.f : mn;
            alpha[j] = __builtin_amdgcn_exp2f(m[h] - mref); chg = chg || (mn > m[h]); m[h] = mn;
            float ps = 0.f;
            if (FAR) { const float bm = on ? (bfar[h] - mref) : -INFINITY;
#pragma unroll
                for (int t = 0; t < 2; ++t)
#pragma unroll
                    for (int r = 0; r < 4; ++r) { const float p = __builtin_amdgcn_exp2f(fmaf(S[t][j][r], QSCALE2, bm)); S[t][j][r] = p; ps += p; }
            } else {
#pragma unroll
                for (int t = 0; t < 2; ++t)
#pragma unroll
                    for (int r = 0; r < 4; ++r) { const float p = __builtin_amdgcn_exp2f(S[t][j][r] - mref); S[t][j][r] = p; ps += p; } }
            l[h] = l[h] * alpha[j] + ps; }
        if (__builtin_amdgcn_ballot_w64(chg) != 0ull) {
#pragma unroll
            for (int j = 0; j < 2; ++j)
#pragma unroll
                for (int dt = 0; dt < 4; ++dt) O[2 * hp + j][dt] *= alpha[j]; }
#pragma unroll
        for (int j = 0; j < 2; ++j) { const long pf = mk64(pk_fp8x4(S[0][j][0], S[0][j][1], S[0][j][2], S[0][j][3]), pk_fp8x4(S[1][j][0], S[1][j][1], S[1][j][2], S[1][j][3]));
#pragma unroll
            for (int dt = 0; dt < 4; ++dt) O[2 * hp + j][dt] = MFMA8(mk64(vr[dt].x, vr[dt].y), pf, O[2 * hp + j][dt]); }
        __builtin_amdgcn_sched_barrier(0);
    }
    nsa_ldv8(vr, vrs, vsoff, vo);
}


__device__ __forceinline__ float max3f(float a, float b, float c) { float r; asm("v_max3_f32 %0, %1, %2, %3" : "=v"(r) : "v"(a), "v"(b), "v"(c)); return r; }
__device__ __forceinline__ float max2f(float a, float b) { float r; asm("v_max_f32 %0, %1, %2" : "=v"(r) : "v"(a), "v"(b)); return r; }
__device__ __forceinline__ float xmax4a(float x) { const auto s = __builtin_amdgcn_permlane16_swap(__float_as_uint(x), __float_as_uint(x), false, false); x = max2f(__uint_as_float(s[0]), __uint_as_float(s[1]));
    const auto t = __builtin_amdgcn_permlane32_swap(__float_as_uint(x), __float_as_uint(x), false, false); return max2f(__uint_as_float(t[0]), __uint_as_float(t[1])); }
__device__ __forceinline__ void slc_block4(const bool far, v4u (&kr)[4], v4u (&vr)[4], const v4u& qf, const int e0, const bool on, const LAS float* lutf  ,
                                           float& m, float& l, f32x4 (&O)[4], brsrc krs, brsrc vrs, int soffn, int ko, int vo) {
    f32x4 S[4];
#pragma unroll
    for (int t = 0; t < 4; ++t) { f32x4 a = {0.f, 0.f, 0.f, 0.f}; a = MFMA8(mk64(kr[t].x, kr[t].y), mk64(qf.x, qf.y), a); S[t] = MFMA8(mk64(kr[t].z, kr[t].w), mk64(qf.z, qf.w), a); }
    { const int o = opq(ko);
#pragma unroll
      for (int t = 0; t < 4; ++t) kr[t] = __builtin_bit_cast(v4u, __builtin_amdgcn_raw_buffer_load_b128(krs, o, soffn + t * 1024, 0)); }
    float alpha, ps = 0.f; bool chg;
    if (far) { const float bfar = lutf[127 * 4];
        float mx = max3f(S[0][0], S[0][1], S[0][2]); mx = max3f(mx, S[0][3], S[1][0]); mx = max3f(mx, S[1][1], S[1][2]); mx = max3f(mx, S[1][3], S[2][0]);
        mx = max3f(mx, S[2][1], S[2][2]); mx = max3f(mx, S[2][3], S[3][0]); mx = max3f(mx, S[3][1], S[3][2]); mx = max2f(mx, S[3][3]);
        const float mxs = on ? fmaf(mx, QSCALE2, bfar) : -INFINITY;
        const float mall = xmax4a(mxs); const float mn = max2f(m, mall); const float mref = (mn == -INFINITY) ? 0.f : mn;
        alpha = __builtin_amdgcn_exp2f(m - mref); chg = mn > m; m = mn;
        const float bm = on ? (bfar - mref) : -INFINITY;
#pragma unroll
        for (int t = 0; t < 4; ++t)
#pragma unroll
            for (int r = 0; r < 4; ++r) { const float p = __builtin_amdgcn_exp2f(fmaf(S[t][r], QSCALE2, bm)); S[t][r] = p; ps += p; }
    } else { float mx = -INFINITY;
#pragma unroll
        for (int t = 0; t < 4; ++t)
#pragma unroll
            for (int r = 0; r < 4; ++r) { const int d = e0 - (16 * t + r); const int li = d < 0 ? 0 : (d > 127 ? 127 : d); const bool ok = on && d >= 0;
                const float bb = lutf[li * 4]; const float s = ok ? fmaf(S[t][r], QSCALE2, bb) : -INFINITY; S[t][r] = s; mx = fmaxf(mx, s); }
        const float mall = xmax4(mx); const float mn = fmaxf(m, mall); const float mref = (mn == -INFINITY) ? 0.f : mn;
        alpha = __builtin_amdgcn_exp2f(m - mref); chg = mn > m; m = mn;
#pragma unroll
        for (int t = 0; t < 4; ++t)
#pragma unroll
            for (int r = 0; r < 4; ++r) { const float p = __builtin_amdgcn_exp2f(S[t][r] - mref); S[t][r] = p; ps += p; } }
    l = l * alpha + ps;
    if (__builtin_amdgcn_ballot_w64(chg) != 0ull) {
#pragma unroll
        for (int dt = 0; dt < 4; ++dt) O[dt] *= alpha; }
    const long pf0 = mk64(pk_fp8x4(S[0][0], S[0][1], S[0][2], S[0][3]), pk_fp8x4(S[1][0], S[1][1], S[1][2], S[1][3]));
    const long pf1 = mk64(pk_fp8x4(S[2][0], S[2][1], S[2][2], S[2][3]), pk_fp8x4(S[3][0], S[3][1], S[3][2], S[3][3]));
#pragma unroll
    for (int dt = 0; dt < 4; ++dt) { O[dt] = MFMA8(mk64(vr[dt].x, vr[dt].y), pf0, O[dt]); O[dt] = MFMA8(mk64(vr[dt].z, vr[dt].w), pf1, O[dt]); }
    { const int o = opq(vo);
#pragma unroll
      for (int dt = 0; dt < 4; ++dt) vr[dt] = __builtin_bit_cast(v4u, __builtin_amdgcn_raw_buffer_load_b128(vrs, o, soffn + dt * 1024, 0)); }
}

struct EfCmp { int n0, nvq, tq; __device__ __forceinline__ EfCmp(int nbase, int g, int nvq_, int tq_) : n0(opq(nbase + 4 * g)), nvq(nvq_), tq(tq_) {}
    __device__ __forceinline__ bool operator()(int t, int r, int& li) const { const int n = n0 + (16 * t + r); const int d = tq - 16 * n - 31; li = d < 0 ? 0 : (d > 127 ? 127 : d); return n < nvq; } };
struct EfWin { int e0; __device__ __forceinline__ EfWin(int nbase, int g, int tq) : e0(opq(tq - nbase - 4 * g)) {}
    __device__ __forceinline__ bool operator()(int t, int r, int& li) const { const int d = e0 - (16 * t + r); li = d < 0 ? 0 : (d > 127 ? 127 : d); return d >= 0 && d < 512; } };
struct EfSlc { int e0; bool sel; __device__ __forceinline__ EfSlc(int nbase, int g, int tq, bool sel_) : e0(opq(tq - nbase - 4 * g)), sel(sel_) {}
    __device__ __forceinline__ bool operator()(int t, int r, int& li) const { const int d = e0 - (16 * t + r); li = d < 0 ? 0 : (d > 127 ? 127 : d); return sel && d >= 0; } };

__device__ __forceinline__ void nsa2_task(Frame& F, int task, LAS float* tab, LAS unsigned* selm, LAS unsigned short* blist, const LAS f32x4* lut16) {
    int lane = lane_id_fresh(), q = lane & 15, g = lane >> 4;
    const int qg = 1023 - (task >> 3), bk = task & 7, b = bk >> 2, kvh = bk & 3;
    const int t0 = qg * 16; int tq = t0 + q;
#define NSA_FRESH() do { lane = opq(lane); q = lane & 15; g = lane >> 4; tq = t0 + q; } while (0)
    const size_t m0 = (size_t)b * T + t0;
    const bf16* Z = (const bf16*)(F.ws + WS_ZA);
    const bf16* zb = Z + (size_t)b * T * NINP;
    const LAS f32x4* lut = lut16 + kvh * 128;
    bf16x8 qf[4][2];
#pragma unroll
    for (int h = 0; h < 4; ++h) { const bf16* p = Z + (m0 + q) * NINP + ZQ + (kvh * 4 + h) * 64 + 8 * g; qf[h][0] = *(const bf16x8*)p; qf[h][1] = *(const bf16x8*)(p + 32); }
    f32x4 O[4][4];
#pragma unroll
    for (int h = 0; h < 4; ++h)
#pragma unroll
        for (int dt = 0; dt < 4; ++dt) O[h][dt] = (f32x4){0.f, 0.f, 0.f, 0.f};
#pragma unroll
    for (int i = 0; i < 64; ++i) tab[i * 64 + lane] = 0.f;
    {
        const int nvq = (tq >= 31) ? ((tq - 31) >> 4) + 1 : 0;
        const int nvmax = (t0 >= 16) ? (t0 >> 4) : 0;
        const int nsteps = (nvmax + 31) >> 5;
        if (nsteps > 0) {
            const bf16* KC = (const bf16*)(F.ws + WS_KC) + (size_t)(b * 4 + kvh) * 1024 * 64;
            const bf16* VCT = (const bf16*)(F.ws + WS_VCT) + (size_t)(b * 4 + kvh) * 64 * 1024;
            float mp[4] = {-INFINITY, -INFINITY, -INFINITY, -INFINITY}, lp[4] = {0.f, 0.f, 0.f, 0.f};
            bf16x8 kf[2][2];
            const brsrc krs = mk_rsrc(KC), vrs = mk_rsrc(VCT); const LdOff lo{q, g, 128, 2048};
            nsa_ldk(kf, krs, 0, lo);
            for (int s = 0; s < nsteps; ++s) {
                const int sn = (s + 1 < nsteps) ? s + 1 : s;
                const bool far = (s * 32 + 31 < nvmax - 1) && (t0 - 16 * (s * 32 + 31) - 31 >= 127);
#pragma unroll
                for (int hp = 0; hp < 2; ++hp) {
                    f32x4 S[2][2]; float mx[2];
                    nsa_qk2(S, kf, qf, hp);
                    if (hp == 1) nsa_ldk(kf, krs, sn * 32 * 64 * 2, lo);
                    if (far) { const f32x4 bfar = lut[127];
#pragma unroll
                        for (int j = 0; j < 2; ++j) { const int h = 2 * hp + j; const float mxh = fmaf(max8(S[0][j], S[1][j]), QSCALE2, bfar[h]); const float mn = fmaxf(mp[h], mxh); const float bm = bfar[h] - mn; float ps = 0.f;
#pragma unroll
                            for (int t = 0; t < 2; ++t)
#pragma unroll
                                for (int r = 0; r < 4; ++r) ps += __builtin_amdgcn_exp2f(fmaf(S[t][j][r], QSCALE2, bm));
                            lp[h] = lp[h] * __builtin_amdgcn_exp2f(mp[h] - mn) + ps; mp[h] = mn; }
                    } else {
                        EfCmp ef(s * 32, g, nvq, tq);
                        nsa_scores_near2(S, ef, lut, mx, hp);
#pragma unroll
                        for (int j = 0; j < 2; ++j) { const int h = 2 * hp + j; const float mn = fmaxf(mp[h], mx[j]); const float mref = (mn == -INFINITY) ? 0.f : mn; float ps = 0.f;
#pragma unroll
                            for (int t = 0; t < 2; ++t)
#pragma unroll
                                for (int r = 0; r < 4; ++r) ps += __builtin_amdgcn_exp2f(S[t][j][r] - mref);
                            lp[h] = lp[h] * __builtin_amdgcn_exp2f(mp[h] - mref) + ps; mp[h] = mn; }
                    }
                    __builtin_amdgcn_sched_barrier(0);
                }
            }
            float mall[4], pscale[4], oscale[4];
#pragma unroll
            for (int h = 0; h < 4; ++h) { const float ma = xmax4(mp[h]); const float mref = (ma == -INFINITY) ? 0.f : ma; const float lt = xsum4(lp[h] * __builtin_amdgcn_exp2f(mp[h] - mref));
                mall[h] = mref; pscale[h] = lt > 0.f ? 1.0f / lt : 0.f;
                oscale[h] = pscale[h] * sigmoidf_(bf2f(Z[(m0 + q) * NINP + ZGT + (kvh * 4 + h) * 3 + 0])); }
            float prev3 = 0.f;
            bf16x8 vf[4];
            nsa_ldk(kf, krs, 0, lo); nsa_ldv(vf, vrs, 0, lo);
            for (int s = 0; s < nsteps; ++s) {
                const int sn = (s + 1 < nsteps) ? s + 1 : s;
                const bool far = (s * 32 + 31 < nvmax - 1) && (t0 - 16 * (s * 32 + 31) - 31 >= 127);
                float psum[2][4];
#pragma unroll
                for (int t = 0; t < 2; ++t)
#pragma unroll
                    for (int r = 0; r < 4; ++r) psum[t][r] = 0.f;
#pragma unroll
                for (int hp = 0; hp < 2; ++hp) {
                    f32x4 S[2][2]; float mx[2];
                    nsa_qk2(S, kf, qf, hp);
                    if (hp == 1) nsa_ldk(kf, krs, sn * 32 * 64 * 2, lo);
                    if (far) { const f32x4 bfar = lut[127];
#pragma unroll
                        for (int t = 0; t < 2; ++t)
#pragma unroll
                            for (int j = 0; j < 2; ++j)
#pragma unroll
                                for (int r = 0; r < 4; ++r) S[t][j][r] = fmaf(S[t][j][r], QSCALE2, bfar[2 * hp + j]);
                    } else { EfCmp ef(s * 32, g, nvq, tq); nsa_scores_near2(S, ef, lut, mx, hp); }
#pragma unroll
                    for (int j = 0; j < 2; ++j)
#pragma unroll
                        for (int t = 0; t < 2; ++t)
#pragma unroll
                            for (int r = 0; r < 4; ++r) { const int h = 2 * hp + j; const float p = __builtin_amdgcn_exp2f(S[t][j][r] - mall[h]); psum[t][r] += p * pscale[h]; S[t][j][r] = p * oscale[h]; }
                    nsa_pv2(O, S, vf, hp);
                    __builtin_amdgcn_sched_barrier(0);
                }
                nsa_ldv(vf, vrs, sn * 32 * 2, lo);
#pragma unroll
                for (int t = 0; t < 2; ++t) { const float x3 = psum[t][3], x4 = (psum[t][0] + psum[t][1]) + (psum[t][2] + x3);
                    const float up = bperm(x3, (lane + 48) & 63);
                    const float wr = bperm(prev3, (lane + 48) & 63);
                    tab[(s * 2 + t) * 64 + lane] = x4 + (g == 0 ? wr : up);
                    prev3 = x3; }
            }
        }
    }
    NSA_FRESH();
    LDS_WAIT(); asm volatile("" ::: "memory");
    {
        float v[64];
        const int cur = t0 >> 6;
        const int c0 = cur - g, c1 = cur - 1 - g, tlim = (tq >> 6) - g;
#pragma unroll
        for (int i = 0; i < 64; ++i) { const float sc = tab[i * 64 + lane]; const bool forced = (4 * i == -g) || (4 * i == c0) || (4 * i == c1); const bool ok = 4 * i <= tlim;
            v[i] = forced ? 1e30f : (ok ? sc : -1e30f); }
        LDS_WAIT(); asm volatile("" ::: "memory");
        { LAS unsigned* tp = (LAS unsigned*)tab;
#pragma unroll
          for (int h = 0; h < 4; ++h)
#pragma unroll
              for (int dt = 0; dt < 4; ++dt) { tp[((h * 4 + dt) * 2 + 0) * 64 + lane] = cvtpk(O[h][dt][0], O[h][dt][1]); tp[((h * 4 + dt) * 2 + 1) * 64 + lane] = cvtpk(O[h][dt][2], O[h][dt][3]); }
          LAS v4u* qd = (LAS v4u*)(tab + 2048) + lane;
#pragma unroll
          for (int h = 0; h < 4; ++h) { const v4u a = __builtin_bit_cast(v4u, qf[h][0]), c = __builtin_bit_cast(v4u, qf[h][1]);
              const v4u w = {pk_fp8x4(bflo(a.x), bfhi(a.x), bflo(a.y), bfhi(a.y)), pk_fp8x4(bflo(a.z), bfhi(a.z), bflo(a.w), bfhi(a.w)), pk_fp8x4(bflo(c.x), bfhi(c.x), bflo(c.y), bfhi(c.y)), pk_fp8x4(bflo(c.z), bfhi(c.z), bflo(c.w), bfhi(c.w))};
              qd[h * 64] = w; } }
        unsigned w0 = 0u, w1 = 0u;
        for (int rnd = 0; rnd < 16; ++rnd) {
            float bv = -INFINITY; int bi = 1 << 18;
#pragma unroll
            for (int i = 0; i < 64; ++i) { if (v[i] > bv) { bv = v[i]; bi = i; } }
            int bj = 4 * bi + g;
            { const float ov = swz16(bv); const int oj = swz16i(bj); if (ov > bv || (ov == bv && oj < bj)) { bv = ov; bj = oj; }
              const auto rv = __builtin_amdgcn_permlane32_swap(__float_as_uint(bv), __float_as_uint(bv), false, false); const auto rj = __builtin_amdgcn_permlane32_swap((unsigned)bj, (unsigned)bj, false, false);
              const float v0 = __uint_as_float(rv[0]), v1 = __uint_as_float(rv[1]); const int j0 = (int)rj[0], j1 = (int)rj[1];
              if (v1 > v0 || (v1 == v0 && j1 < j0)) { bv = v1; bj = j1; } else { bv = v0; bj = j0; } }
            { const bool mine = (bj & 3) == g; const int wi = mine ? (bj >> 2) : -1;
#pragma unroll
              for (int i = 0; i < 64; ++i) { if (wi == i) v[i] = -INFINITY; } }
            if (bv > -1e29f && (bj >> 6) == g) { if (bj & 32) w1 |= 1u << (bj & 31); else w0 |= 1u << (bj & 31); }
        }
        selm[q * 8 + 2 * g] = w0; selm[q * 8 + 2 * g + 1] = w1;
    }
    LDS_WAIT(); asm volatile("" ::: "memory");
    NSA_FRESH();
    {
        int nbl[4];
#pragma unroll
        for (int gp = 0; gp < 4; ++gp) {
            unsigned uw = 0u;
            if (lane < 8) {
#pragma unroll
                for (int qq = 0; qq < 4; ++qq) uw |= selm[(4 * gp + qq) * 8 + lane]; }
            int n = 0;
            for (int w = 0; w < 8; ++w) { unsigned bits = (unsigned)__builtin_amdgcn_readlane((int)uw, w);
                while (bits) { const int j = w * 32 + __builtin_ctz(bits); bits &= bits - 1; if (lane == 0) blist[gp * 64 + n] = (unsigned short)j; ++n; } }
            nbl[gp] = n;
        }
        LDS_WAIT(); asm volatile("" ::: "memory");
        const unsigned char* KS = F.ws + WS_VTS + (size_t)(b * 4 + kvh) * T * 64;
        const unsigned char* VTS = F.ws + WS_VTS + 8 * MiB + (size_t)(b * 4 + kvh) * T * 64;
        const brsrc krs = mk_rsrc(KS), vrs = mk_rsrc(VTS);
#pragma unroll
        for (int pp = 0; pp < 2; ++pp) {
            NSA_FRESH();
            const int qi = q >> 2, hh = q & 3; const int ko = q * 64 + g * 16, vo = q * 64 + g * 16;
            const LAS float* lutf = (const LAS float*)lut + hh;
            f32x4 Og[2][4]; float mg[2] = {-INFINITY, -INFINITY}, lg[2] = {0.f, 0.f};
            v4u kf[2][4], vf[2][4], qf8[2]; int jc[2];
#pragma unroll
            for (int u = 0; u < 2; ++u) { const int gp = 2 * pp + u;
#pragma unroll
                for (int dt = 0; dt < 4; ++dt) Og[u][dt] = (f32x4){0.f, 0.f, 0.f, 0.f};
                const bf16* p = Z + (m0 + 4 * gp + qi) * NINP + ZQ + (kvh * 4 + hh) * 64 + 8 * g; const v4u a = *(const v4u*)p, c = *(const v4u*)(p + 32);
                qf8[u] = (v4u){pk_fp8x4(bflo(a.x), bfhi(a.x), bflo(a.y), bfhi(a.y)), pk_fp8x4(bflo(a.z), bfhi(a.z), bflo(a.w), bfhi(a.w)), pk_fp8x4(bflo(c.x), bfhi(c.x), bflo(c.y), bfhi(c.y)), pk_fp8x4(bflo(c.z), bfhi(c.z), bflo(c.w), bfhi(c.w))};
                jc[u] = __builtin_amdgcn_readfirstlane((int)blist[gp * 64]);
#pragma unroll
                for (int t = 0; t < 4; ++t) { kf[u][t] = __builtin_bit_cast(v4u, __builtin_amdgcn_raw_buffer_load_b128(krs, ko, jc[u] * 4096 + t * 1024, 0)); }
#pragma unroll
                for (int t = 0; t < 4; ++t) { vf[u][t] = __builtin_bit_cast(v4u, __builtin_amdgcn_raw_buffer_load_b128(vrs, vo, jc[u] * 4096 + t * 1024, 0)); } }
            const int nmax = max(nbl[2 * pp], nbl[2 * pp + 1]);
            for (int sb = 0; sb < nmax; ++sb) {
#pragma unroll
                for (int u = 0; u < 2; ++u) { const int gp = 2 * pp + u;
                    const int j = jc[u];
                    const int sn = (sb + 1 < nbl[gp]) ? sb + 1 : nbl[gp] - 1; const int jn = __builtin_amdgcn_readfirstlane((int)blist[gp * 64 + sn]); jc[u] = jn;
                    const bool sel = (sb < nbl[gp]) && ((selm[(4 * gp + qi) * 8 + (j >> 5)] >> (j & 31)) & 1u);
                    const int e0 = opq(t0 + 4 * gp + qi - 64 * j - 4 * g);
                    slc_block4(t0 - (64 * j + 63) >= 127, kf[u], vf[u], qf8[u], e0, sel, lutf, mg[u], lg[u], Og[u], krs, vrs, jn * 4096, ko, vo);
                }
            }
            NSA_FRESH();
            { const int qi2 = q >> 2, hh2 = q & 3;
#pragma unroll
              for (int u = 0; u < 2; ++u) { const int gp = 2 * pp + u; const float lt = xsum4(lg[u]); const float sc = (lt > 0.f ? 1.0f / lt : 0.f) * sigmoidf_(bf2f(Z[(m0 + 4 * gp + qi2) * NINP + ZGT + (kvh * 4 + hh2) * 3 + 1]));
#pragma unroll
                for (int dt = 0; dt < 4; ++dt) { LAS unsigned* tp = (LAS unsigned*)tab; const int slot = ((hh2 * 4 + dt) * 2) * 64 + (4 * gp + qi2) + 16 * g; const unsigned a0 = tp[slot], a1 = tp[slot + 64];
                    tp[slot] = cvtpk(bflo(a0) + Og[u][dt][0] * sc, bfhi(a0) + Og[u][dt][1] * sc); tp[slot + 64] = cvtpk(bflo(a1) + Og[u][dt][2] * sc, bfhi(a1) + Og[u][dt][3] * sc); } } }
        }
        LDS_WAIT(); asm volatile("" ::: "memory");
    }
    NSA_FRESH();
    {
#pragma unroll
        for (int h = 0; h < 4; ++h)
#pragma unroll
            for (int dt = 0; dt < 4; ++dt) O[h][dt] = (f32x4){0.f, 0.f, 0.f, 0.f};
        float m[4] = {-INFINITY, -INFINITY, -INFINITY, -INFINITY}, l[4] = {0.f, 0.f, 0.f, 0.f};
        const unsigned char* KW = F.ws + WS_VTW + (size_t)(b * 4 + kvh) * T * 64;
        const unsigned char* VTW = F.ws + WS_VTW + 8 * MiB + (size_t)(b * 4 + kvh) * T * 64;
        int ks = t0 - 511; ks = ks < 0 ? 0 : (ks & ~31);
        const int kend = t0 + 16;
        v4u kf[2]; v2u vf[4];
        const brsrc krs = mk_rsrc(KW), vrs = mk_rsrc(VTW); const int ko = q * 64 + g * 16, vo = q * 64 + g * 16;
        nsa_ldk8(kf, krs, ks * 64, ko); nsa_ldv8(vf, vrs, (ks >> 6) * 4096 + ((ks & 32) >> 2), vo);
        for (int nb = ks; nb < kend; nb += 32) {
            const int nn = (nb + 32 < kend) ? nb + 32 : nb;
            EfWin ef(nb, g, tq);
            if (t0 - (nb + 31) >= 127 && t0 + 15 - nb <= 511) nsa_step_online8<true>(kf, vf, (const LAS v4u*)(tab + 2048) + lane, ef, lut, true, m, l, O, krs, nn * 64, vrs, (nn >> 6) * 4096 + ((nn & 32) >> 2), ko, vo);
            else nsa_step_online8<false>(kf, vf, (const LAS v4u*)(tab + 2048) + lane, ef, lut, true, m, l, O, krs, nn * 64, vrs, (nn >> 6) * 4096 + ((nn & 32) >> 2), ko, vo);
        }
        bf16* Y = (bf16*)(F.ws + WS_H);
        NSA_FRESH();
#pragma unroll
        for (int h = 0; h < 4; ++h) { const float lt = xsum4(l[h]); const float sc = (lt > 0.f ? 1.0f / lt : 0.f) * sigmoidf_(bf2f(Z[(m0 + q) * NINP + ZGT + (kvh * 4 + h) * 3 + 2]));
#pragma unroll
            for (int dt = 0; dt < 4; ++dt) { const LAS unsigned* tp = (const LAS unsigned*)tab; const unsigned a0 = tp[((h * 4 + dt) * 2 + 0) * 64 + lane], a1 = tp[((h * 4 + dt) * 2 + 1) * 64 + lane];
                v2u w; w.x = cvtpk(bflo(a0) + O[h][dt][0] * sc, bfhi(a0) + O[h][dt][1] * sc); w.y = cvtpk(bflo(a1) + O[h][dt][2] * sc, bfhi(a1) + O[h][dt][3] * sc);
                *(v2u*)(Y + (m0 + q) * D + (kvh * 4 + h) * 64 + 16 * dt + 4 * g) = w; } }
    }
    LDS_WAIT(); asm volatile("" ::: "memory");
#undef NSA_FRESH
}

__device__ __forceinline__ void ph_vtrans(Frame& F) {
    const bf16* Z = (const bf16*)(F.ws + WS_ZA);
    LAS unsigned short* tl = (LAS unsigned short*)(F.lds + F.wave * 8704);
    const int gw = F.bid * NWAVES + F.wave, NGW = F.G * NWAVES;
    for (int it = gw; it < 2 * NB * 4 * 256; it += NGW) {
        const int blk = it & 255, kvh = (it >> 8) & 3, b = (it >> 10) & 1, which = it >> 11;
        const bf16* src = Z + ((size_t)b * T + blk * 64) * NINP + (which ? ZVW : ZVS) + kvh * 64;
        const bf16* ksrc = Z + ((size_t)b * T + blk * 64) * NINP + (which ? ZKW : ZKS) + kvh * 64;
        unsigned char* k8 = F.ws + (which ? WS_VTW : WS_VTS) + ((size_t)(b * 4 + kvh) * T + blk * 64) * 64;
        unsigned char* v8 = k8 + 8 * MiB;
#pragma unroll
        for (int i = 0; i < 8; ++i) { const int tok = i * 8 + (F.lane >> 3), c8 = (F.lane & 7) * 8; const v4u w = *(const v4u*)(src + (size_t)tok * NINP + c8);
            LAS unsigned* p = (LAS unsigned*)(tl + tok * 68 + c8); p[0] = w.x; p[1] = w.y; p[2] = w.z; p[3] = w.w; }
#pragma unroll
        for (int i = 0; i < 8; ++i) { const int tok = i * 8 + (F.lane >> 3), c8 = (F.lane & 7) * 8; const v4u w = *(const v4u*)(ksrc + (size_t)tok * NINP + c8);
            v2u o; o.x = pk_fp8x4(bflo(w.x), bfhi(w.x), bflo(w.y), bfhi(w.y)); o.y = pk_fp8x4(bflo(w.z), bfhi(w.z), bflo(w.w), bfhi(w.w));
            *(v2u*)(k8 + tok * 64 + 16 * ((c8 & 31) >> 3) + 8 * (c8 >> 5)) = o; }
        LDS_WAIT(); asm volatile("" ::: "memory");
#pragma unroll
        for (int i = 0; i < 8; ++i) { const int d = i * 8 + (F.lane >> 3), t8 = (F.lane & 7) * 8; const int kb = ((t8 >> 3) & 1) * 32 + (t8 >> 4) * 4; float e[8];
#pragma unroll
            for (int k = 0; k < 8; ++k) e[k] = __uint_as_float((unsigned)tl[(kb + (k < 4 ? k : 12 + k)) * 68 + d] << 16);
            v2u o; o.x = pk_fp8x4(e[0], e[1], e[2], e[3]); o.y = pk_fp8x4(e[4], e[5], e[6], e[7]);
            *(v2u*)(v8 + d * 64 + t8) = o; }
        LDS_WAIT(); asm volatile("" ::: "memory");
    }
}
#ifndef SCAN_PARTNER
#define SCAN_PARTNER 4
#endif
__device__ __forceinline__ void ph_nsa2_scan(Frame& F, int l) {
    LAS f32x4* lut16 = (LAS f32x4*)F.lds;
    LAS unsigned char* wbase = F.lds + 8192 + ((F.wave + 7) & 7) * 17408;
    LAS float* tab = (LAS float*)wbase; LAS unsigned* selm = (LAS unsigned*)(wbase + 16384); LAS unsigned short* blist = (LAS unsigned short*)(wbase + 16896);
    for (int i = F.tid; i < 512; i += NTHREADS) { const int kvh = i >> 7, d = i & 127; const int bk = rel_bucket_dev(d); const float* tb = F.inp(2);
        lut16[i] = (f32x4){tb[(kvh * 4 + 0) * 32 + bk], tb[(kvh * 4 + 1) * 32 + bk], tb[(kvh * 4 + 2) * 32 + bk], tb[(kvh * 4 + 3) * 32 + bk]} * LOG2E; }
    volatile LAS unsigned* scan_done = (volatile LAS unsigned*)(F.lds + LDS_MISC + 64);
    if (F.tid == 0) *scan_done = 0u;
    __syncthreads();
#ifdef PROBE_SCAN_TWICE
    int nscan = 2; asm volatile("" : "+s"(nscan));
#else
    const int nscan = 1;
#endif
    if (F.wave == 0) { for (int rep = 0; rep < nscan; ++rep) for (int gi = F.bid; gi < 256; gi += F.G) rwkv_scan_v2(F, ((gi & 7) * 2 + ((gi >> 3) >> 4)) * 16 + ((gi >> 3) & 15));
        if (F.lane == 0) *scan_done = 1u; LDS_WAIT(); }
#ifndef SCAN_IDLE_MASK
#define SCAN_IDLE_MASK (1u << SCAN_PARTNER)
#endif
    if ((SCAN_IDLE_MASK >> F.wave) & 1u) {
        if (l < 2) { unsigned* qd = (unsigned*)(F.ws + WS_CTL) + CW_NSAQ + 1024 * 6 + 64 * l; const int ndef = (l == 0) ? WC_NDEFER0 : WC_NDEFER1;
            while (*scan_done == 0u) {
                int d = 0;
                if (F.lane == 0) d = (int)__hip_atomic_fetch_add(qd, 1u, __ATOMIC_RELAXED, __HIP_MEMORY_SCOPE_AGENT);
                d = __builtin_amdgcn_readfirstlane(d);
                if (d >= ndef) break;
                wconv_item(F, wconv_deferred(l, d), (LAS float*)((LAS unsigned char*)tab + 1024), lane_id_fresh());
            } }
        while (*scan_done == 0u) __builtin_amdgcn_s_sleep(64); }
#ifdef PROBE_NSAT
    int ntr = 2; asm volatile("" : "+s"(ntr));
#else
    const int ntr = 1;
#endif
    for (int tr = 0; tr < ntr; ++tr) {
    unsigned* qc = (unsigned*)(F.ws + WS_CTL) + CW_NSAQ + 1024 * (l + 2 * tr); const int xcc = (int)(xb_xcc_id() & 7u);
    for (int y = 0; y < 8; ++y) { const int x = (xcc + y) & 7;
        for (;;) {
            int t = 0;
            if (F.lane == 0) t = (int)__hip_atomic_fetch_add(qc + 64 * x, 1u, __ATOMIC_RELAXED, __HIP_MEMORY_SCOPE_AGENT);
            t = __builtin_amdgcn_readfirstlane(t);
            if (t >= 1024) break;
            nsa2_task(F, t * 8 + x, tab, selm, blist, lut16);
        } }
    }
    if (l < 2) {
        unsigned* qd = (unsigned*)(F.ws + WS_CTL) + CW_NSAQ + 1024 * 6 + 64 * l; const int ndef = (l == 0) ? WC_NDEFER0 : WC_NDEFER1;
        for (;;) {
            int d = 0;
            if (F.lane == 0) d = (int)__hip_atomic_fetch_add(qd, 1u, __ATOMIC_RELAXED, __HIP_MEMORY_SCOPE_AGENT);
            d = __builtin_amdgcn_readfirstlane(d);
            if (d >= ndef) break;
            wconv_item(F, wconv_deferred(l, d), tab, lane_id_fresh());
        }
    }
}

constexpr int NPL = 16, NPHASES = 2 + DEPTH * NPL;
#ifndef MK_ONE_LAUNCH
#define MK_ONE_LAUNCH 1
#endif
__global__ void __launch_bounds__(NTHREADS, 2) fwd_kernel(Args args) {
    extern __shared__ __attribute__((aligned(16))) unsigned char lds_raw[];
    Frame F;
    F.lds = (LAS unsigned char*)lds_raw; F.wave = __builtin_amdgcn_readfirstlane(threadIdx.x >> 6); asm volatile("" : "+s"(F.wave)); F.lane = lane_id_fresh(); F.tid = F.wave * 64 + F.lane;
    F.G = gridDim.x; F.bid = blockIdx.x; F.out = args.out; F.ws = args.ws;
    F.inl = (const LAS unsigned long long*)(F.lds + LDS_MISC + 256);
    if (F.tid < 29) ((LAS unsigned long long*)(F.lds + LDS_MISC + 256))[F.tid] = (unsigned long long)args.in[F.tid];
    volatile LAS unsigned* MISC = (volatile LAS unsigned*)(F.lds + LDS_MISC);
    if (F.tid < 64) MISC[F.tid] = 0u;
    __syncthreads();
    unsigned* ctl = (unsigned*)(F.ws + WS_CTL);
#if 0
#define IN(p) true
#define USE_BAR true
#else
    const int lo = args.lo, hi = args.hi;
#define IN(p) (lo <= (p) && (p) < hi)
#define USE_BAR (args.use_bar != 0)
#endif
    XcdBarrier bar; bar.bar = ctl + CW_BAR; bar.x = 0; bar.st = nullptr;
    if (USE_BAR) bar = xcd_barrier_post(ctl + CW_BAR, MISC, F.tid);
#define FRESH() do { asm volatile("" : "+s"(F.bid)); asm volatile("" : "+s"(F.G)); asm volatile("" : "+s"(F.ws)); asm volatile("" : "+s"(F.out)); F.lane = lane_id_fresh(); F.tid = F.wave * 64 + F.lane; } while (0)
#define SEAM(p) do { if (IN((p) + 1)) { if (USE_BAR) { F.lane = lane_id_fresh(); F.tid = F.wave * 64 + F.lane; xcd_barrier(bar, F.tid); } } } while (0)
    PG8_LAS unsigned char* glds = (PG8_LAS unsigned char*)lds_raw;
#define Hb ((const pg8::bf16_t*)(F.ws + WS_H))
#define ZAb ((pg8::bf16_t*)(F.ws + WS_ZA))
#define modl ((const float*)(F.ws + WS_MOD) + (size_t)l * NB * MODW)

    if (IN(0)) { FRESH(); ph_prologue(F); SEAM(0); }
    for (int l = 0; l < DEPTH; ++l) {
        const int pb = 1 + NPL * l;
        if (IN(pb + 0)) { FRESH(); if (l == 0) ph_adaln<false>(F, F.inp(0), nullptr, l, 0); else ph_adaln<true>(F, F.out, (const bf16*)(F.ws + WS_H), l, 0); SEAM(pb + 0); }
        if (IN(pb + 1)) { FRESH();
            pg8::Gemm g{Hb, (const pg8::bf16_t*)(F.ws + WS_WGU) + (size_t)(l * 2 + 0) * 2 * FF * D, M, 2 * FF, D}; pg8::StaticOrder S; S.init(M, 2 * FF, F.G, F.bid);
            pg8::EpiSwiGLU E{ZAb, FF};
            pg8::gemm_phase<pg8::EpiSwiGLU, pg8::StaticOrder, true, true>(glds, g, S, E, F.tid);
            SEAM(pb + 1); }
        if (IN(pb + 2)) { FRESH();
            pg8::Gemm g{ZAb, (const pg8::bf16_t*)(F.ws + WS_WD) + (size_t)(l * 2 + 0) * D * FF, M, D, FF}; pg8::StaticOrder S; S.init(M, D, F.G, F.bid);
            pg8::EpiGateBf16<D, MODW, T, 1> E{(pg8::bf16_t*)(F.ws + WS_H), modl + (0 * 3 + 2) * D};
            pg8::gemm_phase<decltype(E), pg8::StaticOrder, true, true>(glds, g, S, E, F.tid);
            SEAM(pb + 2); }
        if (IN(pb + 3)) { FRESH(); ph_adaln<true>(F, (l == 0) ? F.inp(0) : F.out, (const bf16*)(F.ws + WS_H), l, 1); SEAM(pb + 3); }
        if (IN(pb + 4)) { FRESH();
            pg8::Gemm g{Hb, (const pg8::bf16_t*)(F.ws + WS_WIN) + (size_t)l * NINP * D, M, NINP, D}; pg8::StaticOrder S; S.init(M, NINP, F.G, F.bid);
            pg8::EpiPlainBf16 E{ZAb, NINP};
            pg8::gemm_phase<pg8::EpiPlainBf16, pg8::StaticOrder, true, true>(glds, g, S, E, F.tid);
            SEAM(pb + 4); }
#ifndef SKIP_MIXER
#ifdef PROBE_P5
        int p5r = 2; asm volatile("" : "+s"(p5r));
#else
        const int p5r = 1;
#endif
        for (int r5 = 0; r5 < p5r; ++r5)
        if (IN(pb + 5)) { FRESH(); ph_vtrans(F); __syncthreads();
#ifdef PROBE_CMP
            { int cr_ = 2; asm volatile("" : "+s"(cr_)); for (int c_ = 0; c_ < cr_; ++c_) { ph_compress(F, l); __syncthreads(); } }
#else
            ph_compress2(F, l);
#endif
#ifdef PROBE_RW1
            { int rr_ = 2; asm volatile("" : "+s"(rr_)); for (int c_ = 0; c_ < rr_; ++c_) { ph_rwkv2_tok<0>(F, l); __syncthreads(); } }
#else
            ph_rwkv2_tok<0>(F, l);
#endif
            SEAM(pb + 5); }
        if (IN(pb + 6)) {
#ifdef PROBE_NSA_TWICE
            int nrep = 2; asm volatile("" : "+s"(nrep));
#else
            const int nrep = 1;
#endif
            for (int rep = 0; rep < nrep; ++rep) { FRESH(); ph_nsa2_scan(F, l + 2 * rep); __syncthreads(); }
            SEAM(pb + 6); }
        if (IN(pb + 7)) { FRESH(); ph_rwkv2_tok<1>(F, l); SEAM(pb + 7); }
#ifdef PROBE_ML
        int pmr = 2; asm volatile("" : "+s"(pmr));
#else
        const int pmr = 1;
#endif
        for (int rm = 0; rm < pmr; ++rm) {
        if (IN(pb + 8)) { FRESH(); ph_mlA(F, l); SEAM(pb + 9); }
        if (IN(pb + 10)) { FRESH(); ph_mlB(F); SEAM(pb + 10); }
        if (IN(pb + 11)) { FRESH(); ph_mlC(F, l); SEAM(pb + 11); }
        }
        if (IN(pb + 12)) { FRESH();
            pg8::Gemm g{Hb, (const pg8::bf16_t*)(F.ws + WS_WOUT) + (size_t)l * D * D, M, D, D}; pg8::StaticOrder S; S.init(M, D, F.G, F.bid);
            pg8::EpiGateBf16<D, MODW, T, 2> E{(pg8::bf16_t*)(F.ws + WS_ZA), modl + (1 * 3 + 2) * D};
            pg8::gemm_phase<decltype(E), pg8::StaticOrder, true, true>(glds, g, S, E, F.tid);
            SEAM(pb + 12); }
#endif
        if (IN(pb + 13)) { FRESH(); ph_adaln<true>(F, F.out, (const bf16*)(F.ws + WS_ZA), l, 2); SEAM(pb + 13); }
        if (IN(pb + 14)) { FRESH();
            pg8::Gemm g{Hb, (const pg8::bf16_t*)(F.ws + WS_WGU) + (size_t)(l * 2 + 1) * 2 * FF * D, M, 2 * FF, D}; pg8::StaticOrder S; S.init(M, 2 * FF, F.G, F.bid);
            pg8::EpiSwiGLU E{ZAb, FF};
            pg8::gemm_phase<pg8::EpiSwiGLU, pg8::StaticOrder, true, true>(glds, g, S, E, F.tid);
            SEAM(pb + 14); }
        if (IN(pb + 15)) { FRESH();
            pg8::Gemm g{ZAb, (const pg8::bf16_t*)(F.ws + WS_WD) + (size_t)(l * 2 + 1) * D * FF, M, D, FF}; pg8::StaticOrder S; S.init(M, D, F.G, F.bid);
            pg8::EpiGateBf16<D, MODW, T, 1> E{(pg8::bf16_t*)(F.ws + WS_H), modl + (2 * 3 + 2) * D};
            pg8::gemm_phase<decltype(E), pg8::StaticOrder, true, true>(glds, g, S, E, F.tid);
            SEAM(pb + 15); }
    }
    if (IN(NPHASES - 1)) { FRESH(); ph_final(F); }
#undef IN
#undef USE_BAR
#undef SEAM
}

extern "C" void kernel_launch(void* const* d_in, const int* in_sizes, int n_in, void* d_out, int out_size, void* d_ws, size_t ws_size, hipStream_t stream) {
    static int grid = 0;
    if (grid == 0) {
        if (n_in != 29 || in_sizes[0] != M * D || out_size != M * D || ws_size < WS_END3) { fprintf(stderr, "kernel_launch: unexpected problem (n_in %d, in0 %d, out %d, ws %zu < %zu?)\n", n_in, n_in > 0 ? in_sizes[0] : -1, out_size, ws_size, (size_t)WS_END3); grid = -1; return; }
        int dev = 0, cus = 0, per_cu = 0;
        if (hipGetDevice(&dev) != hipSuccess || hipDeviceGetAttribute(&cus, hipDeviceAttributeMultiprocessorCount, dev) != hipSuccess) { grid = -1; return; }
        if (hipFuncSetAttribute((const void*)fwd_kernel, hipFuncAttributeMaxDynamicSharedMemorySize, LDS_BYTES) != hipSuccess) { fprintf(stderr, "kernel_launch: hipFuncSetAttribute failed\n"); grid = -1; return; }
        if (hipOccupancyMaxActiveBlocksPerMultiprocessor(&per_cu, (const void*)fwd_kernel, NTHREADS, LDS_BYTES) != hipSuccess || per_cu < 1) fprintf(stderr, "kernel_launch: occupancy query says %d\n", per_cu);
        (void)hipGetLastError();
        grid = cus;
    }
    if (grid < 0) return;
    if (hipMemsetAsync((char*)d_ws + WS_CTL, 0, CTL_ZERO_BYTES, stream) != hipSuccess) return;
    Args a{};
    for (int i = 0; i < 29; ++i) a.in[i] = (const float*)d_in[i];
    a.out = (float*)d_out; a.ws = (unsigned char*)d_ws; a.pad = 0;
#if MK_ONE_LAUNCH
    a.lo = 0; a.hi = NPHASES; a.use_bar = 1;
    hipLaunchKernelGGL(fwd_kernel, dim3(grid), dim3(NTHREADS), LDS_BYTES, stream, a);
#else
    for (int p = 0; p < NPHASES; ++p) { a.lo = p; a.hi = p + 1; a.use_bar = 0;
        hipLaunchKernelGGL(fwd_kernel, dim3(grid), dim3(NTHREADS), LDS_BYTES, stream, a); }
#endif
}
```
